# Optimizing an MI355X kernel written in HIP

```python
import math
import jax
import jax.numpy as jnp
from jax import lax
import numpy as np

D_MODEL = 1024
BATCH = 8
SEQ = 4096
DEPTH = 2

GRID_W = 64
CTX_LEN = 256
EPS = 1e-6
ROPE_BASE = 10000.0
NEG_INF = -1e30
Q_BLOCK = 128

MLA_HEADS = 8
MLA_NOPE = 64
MLA_ROPE = 32
MLA_V = 64
MLA_QK = MLA_NOPE + MLA_ROPE
MLA_Q_LORA = 384
MLA_KV_LORA = 256

S5_WIDTH = 512
S5_GROUP = 16
S5_GROUPS = S5_WIDTH // S5_GROUP
S5_STATE = 64
S5_DT_MIN = 1e-3
S5_DT_MAX = 1e-1
S5_MAX_RE = -1e-4

SWA_HEADS = 8
SWA_KV_HEADS = 2
SWA_GROUP = SWA_HEADS // SWA_KV_HEADS
SWA_HEAD_DIM = 64
SWA_WINDOW = 128
SWA_BLOCK = 128
SWA_SPAN = SWA_BLOCK + 2 * SWA_WINDOW

N_BRANCH = 3
BRANCH_WIDTH = 512
FFN_HIDDEN = ((8 * D_MODEL + 3 * 256 - 1) // (3 * 256)) * 256

IN_SIZES = (MLA_Q_LORA, MLA_KV_LORA, MLA_ROPE, S5_WIDTH, SWA_HEADS * SWA_HEAD_DIM,
            2 * SWA_KV_HEADS * SWA_HEAD_DIM, N_BRANCH * D_MODEL)
IN_SPLITS = tuple(int(s) for s in np.cumsum(IN_SIZES)[:-1])
D_IN = sum(IN_SIZES)

kernel_name = 'hybrid_mla_s5_swa_dit_block'


def rms_norm(x, g):
    xf = x.astype(jnp.float32)
    y = xf * lax.rsqrt(jnp.mean(xf * xf, axis=-1, keepdims=True) + EPS)
    return (y * g.astype(jnp.float32)).astype(x.dtype)


def modulate(h, shift, scale):
    return h * (1 + scale[:, None]) + shift[:, None]


def axial_rope_angles(row, col, rot_dim):
    n_axis = rot_dim // 4
    freqs = ROPE_BASE ** (-jnp.arange(n_axis, dtype=jnp.float32) / n_axis)
    return jnp.concatenate([row[:, None] * freqs, col[:, None] * freqs], axis=-1)


def apply_rope(x, ang):
    cos = jnp.cos(ang)[:, None, :]
    sin = jnp.sin(ang)[:, None, :]
    xf = x.astype(jnp.float32)
    half = x.shape[-1] // 2
    x1, x2 = xf[..., :half], xf[..., half:]
    return jnp.concatenate([x1 * cos - x2 * sin, x2 * cos + x1 * sin], axis=-1).astype(x.dtype)


def full_attention(q, k, v):
    s = jnp.einsum('bqhd,bkhd->bhqk', q, k).astype(jnp.float32) * (q.shape[-1] ** -0.5)
    p = jax.nn.softmax(s, axis=-1).astype(v.dtype)
    return jnp.einsum('bhqk,bkhv->bqhv', p, v)


def blocked_dense_attention(q, k, v):
    b, n, h, d = q.shape
    nb = n // Q_BLOCK
    qb = jnp.moveaxis(q.reshape(b, nb, Q_BLOCK, h, d), 1, 0)
    out = lax.map(lambda qblk: full_attention(qblk, k, v), qb)
    return jnp.moveaxis(out, 0, 1).reshape(b, n, h * v.shape[-1])


def mla_project(q_in, kv_in, kr_in, qa_g, kva_g, w_uq, w_ukv, qk_g, ang):
    b, n, _ = q_in.shape
    q = (rms_norm(q_in, qa_g) @ w_uq).reshape(b, n, MLA_HEADS, MLA_QK)
    kv = (rms_norm(kv_in, kva_g) @ w_ukv).reshape(b, n, MLA_HEADS, MLA_NOPE + MLA_V)
    k_nope, v = kv[..., :MLA_NOPE], kv[..., MLA_NOPE:]
    k_pe = jnp.broadcast_to(kr_in[:, :, None, :], (b, n, MLA_HEADS, MLA_ROPE))
    k = jnp.concatenate([k_nope, k_pe], axis=-1)
    q = rms_norm(q, qk_g[0])
    k = rms_norm(k, qk_g[1])
    if ang is not None:
        q = jnp.concatenate([q[..., :MLA_NOPE], apply_rope(q[..., MLA_NOPE:], ang)], axis=-1)
        k = jnp.concatenate([k[..., :MLA_NOPE], apply_rope(k[..., MLA_NOPE:], ang)], axis=-1)
    return q, k, v


def swa_project(q_in, kv_in, qk_g, ang):
    b, n, _ = q_in.shape
    q = rms_norm(q_in.reshape(b, n, SWA_HEADS, SWA_HEAD_DIM), qk_g[0])
    k, v = jnp.split(kv_in.reshape(b, n, 2 * SWA_KV_HEADS, SWA_HEAD_DIM), 2, axis=2)
    k = rms_norm(k, qk_g[1])
    if ang is not None:
        q = apply_rope(q, ang)
        k = apply_rope(k, ang)
    return q.reshape(b, n, SWA_KV_HEADS, SWA_GROUP, SWA_HEAD_DIM), k, v


def sink_softmax(parts, sink):
    s0 = parts[0]
    s_sink = jnp.broadcast_to(sink.astype(jnp.float32).reshape(SWA_KV_HEADS, SWA_GROUP)[None, :, :, None, None],
                              s0.shape[:-1] + (1,))
    p = jax.nn.softmax(jnp.concatenate([s_sink] + parts, axis=-1), axis=-1)
    return p[..., 1:]


def swa_latent(q, k, v, k_ctx, v_ctx, sink):
    b, n = q.shape[0], q.shape[1]
    nb = n // SWA_BLOCK
    n_ctx = k_ctx.shape[1]
    scale = SWA_HEAD_DIM ** -0.5
    qb = jnp.moveaxis(q.reshape(b, nb, SWA_BLOCK, SWA_KV_HEADS, SWA_GROUP, SWA_HEAD_DIM), 1, 0)
    pad = ((0, 0), (SWA_WINDOW, SWA_WINDOW), (0, 0), (0, 0))
    kpad = jnp.pad(k, pad)
    vpad = jnp.pad(v, pad)

    def one(args):
        qblk, idx = args
        start = idx * SWA_BLOCK
        kb = lax.dynamic_slice_in_dim(kpad, start, SWA_SPAN, axis=1)
        vb = lax.dynamic_slice_in_dim(vpad, start, SWA_SPAN, axis=1)
        s_band = jnp.einsum('bqkgd,bjkd->bkgqj', qblk, kb).astype(jnp.float32) * scale
        qpos = start + jnp.arange(SWA_BLOCK)
        kpos = start - SWA_WINDOW + jnp.arange(SWA_SPAN)
        valid = (jnp.abs(qpos[:, None] - kpos[None, :]) <= SWA_WINDOW) & (kpos[None, :] >= 0) & (kpos[None, :] < n)
        s_band = jnp.where(valid, s_band, NEG_INF)
        s_ctx = jnp.einsum('bqkgd,bjkd->bkgqj', qblk, k_ctx).astype(jnp.float32) * scale
        p = sink_softmax([s_ctx, s_band], sink)
        p_ctx = p[..., :n_ctx].astype(v.dtype)
        p_band = p[..., n_ctx:].astype(v.dtype)
        return (jnp.einsum('bkgqj,bjkd->bqkgd', p_band, vb)
                + jnp.einsum('bkgqj,bjkd->bqkgd', p_ctx, v_ctx))

    out = lax.map(one, (qb, jnp.arange(nb)))
    return jnp.moveaxis(out, 0, 1).reshape(b, n, SWA_HEADS * SWA_HEAD_DIM)


def swa_context(q, k, v, sink):
    b, n = q.shape[0], q.shape[1]
    s = jnp.einsum('bqkgd,bjkd->bkgqj', q, k).astype(jnp.float32) * (SWA_HEAD_DIM ** -0.5)
    p = sink_softmax([s], sink).astype(v.dtype)
    return jnp.einsum('bkgqj,bjkd->bqkgd', p, v).reshape(b, n, SWA_HEADS * SWA_HEAD_DIM)


def s5_params(lam_re, lam_im, log_step, b_re, b_im, c_re, c_im):
    lam = lax.complex(jnp.minimum(lam_re.astype(jnp.float32), S5_MAX_RE), lam_im.astype(jnp.float32))
    dt = jnp.exp(log_step.astype(jnp.float32))[:, None]
    a_bar = jnp.exp(lam * dt)
    b_mat = lax.complex(b_re.astype(jnp.float32), b_im.astype(jnp.float32))
    b_bar = ((a_bar - 1.0) / lam)[..., None] * b_mat
    c_mat = lax.complex(c_re.astype(jnp.float32), c_im.astype(jnp.float32))
    return a_bar, b_bar, c_mat


def s5_combine(e1, e2):
    a1, b1 = e1
    a2, b2 = e2
    return a1 * a2, a2 * b1 + b2


def s5_scan(u, a_bar, b_bar, h0, reverse):
    n = u.shape[1]
    bu = jnp.einsum('bngi,gpi->bngp', u.astype(jnp.complex64), b_bar)
    a = jnp.broadcast_to(a_bar[None, None], (1, n) + a_bar.shape)
    a_cum, h = lax.associative_scan(s5_combine, (a, bu), axis=1, reverse=reverse)
    if h0 is not None:
        h = h + a_cum * h0[:, None]
    return h


def s5_readout(h_f, h_b, u, c_f, c_b, d, w_glu, b_glu, dtype):
    b, n = u.shape[0], u.shape[1]
    y = jnp.real(jnp.einsum('bngp,gip->bngi', h_f, c_f) + jnp.einsum('bngp,gip->bngi', h_b, c_b))
    y = y + d.astype(jnp.float32).reshape(S5_GROUPS, S5_GROUP) * u
    y = jax.nn.gelu(y.reshape(b, n, S5_WIDTH).astype(dtype))
    return y * jax.nn.sigmoid(y @ w_glu + b_glu)


def merge_branches(mla_o, s5_o, swa_o, gate_in, w_branch, w_out):
    b, n, _ = mla_o.shape
    branches = jnp.stack([mla_o, s5_o, swa_o], axis=0)
    proj = jnp.einsum('rbnc,rcd->rbnd', branches, w_branch)
    gates = jax.nn.sigmoid(jnp.moveaxis(gate_in.reshape(b, n, N_BRANCH, D_MODEL), 2, 0))
    return jnp.sum(gates * proj, axis=0) @ w_out


def swiglu(h, w_in, w_out):
    a, g = jnp.split(h @ w_in, 2, axis=-1)
    return (jax.nn.silu(a) * g) @ w_out


def setup_inputs(seed: int = 0):
    key = jax.random.key(seed)
    ks = jax.random.split(key, 32)
    f32 = jnp.float32

    def nrm(k, shape, scale):
        return jax.random.normal(k, shape, f32) * scale

    def gain(k, shape):
        return 1.0 + 0.05 * jax.random.normal(k, shape, f32)

    L = DEPTH
    n_idx = jnp.arange(S5_STATE, dtype=f32)
    return {
        'x': nrm(ks[0], (BATCH, SEQ, D_MODEL), 1.0),
        'c': nrm(ks[1], (BATCH, D_MODEL), 1.0),
        'ctx': nrm(ks[2], (BATCH, CTX_LEN, D_MODEL), 1.0),
        'c_ctx': nrm(ks[3], (D_MODEL,), 1.0),
        'w_ada': nrm(ks[4], (L, D_MODEL, 6 * D_MODEL), 0.5 * D_MODEL ** -0.5),
        'b_ada': nrm(ks[5], (L, 6 * D_MODEL), 0.02),
        'norm1_g': gain(ks[6], (L, D_MODEL)),
        'norm2_g': gain(ks[7], (L, D_MODEL)),
        'w_in': nrm(ks[8], (L, D_MODEL, D_IN), D_MODEL ** -0.5),
        'mla_qa_g': gain(ks[9], (L, MLA_Q_LORA)),
        'mla_kva_g': gain(ks[10], (L, MLA_KV_LORA)),
        'mla_w_uq': nrm(ks[11], (L, MLA_Q_LORA, MLA_HEADS * MLA_QK), MLA_Q_LORA ** -0.5),
        'mla_w_ukv': nrm(ks[12], (L, MLA_KV_LORA, MLA_HEADS * (MLA_NOPE + MLA_V)), MLA_KV_LORA ** -0.5),
        'mla_qk_g': gain(ks[13], (L, 2, MLA_QK)),
        's5_lambda_re': -0.5 + nrm(ks[14], (L, 2, S5_GROUPS, S5_STATE), 0.01),
        's5_lambda_im': jnp.pi * n_idx + nrm(ks[15], (L, 2, S5_GROUPS, S5_STATE), 0.01),
        's5_log_step': jax.random.uniform(ks[16], (L, 2, S5_GROUPS), f32, math.log(S5_DT_MIN), math.log(S5_DT_MAX)),
        's5_b_re': nrm(ks[17], (L, 2, S5_GROUPS, S5_STATE, S5_GROUP), (2 * S5_GROUP) ** -0.5),
        's5_b_im': nrm(ks[18], (L, 2, S5_GROUPS, S5_STATE, S5_GROUP), (2 * S5_GROUP) ** -0.5),
        's5_c_re': nrm(ks[19], (L, 2, S5_GROUPS, S5_GROUP, S5_STATE), 0.5),
        's5_c_im': nrm(ks[20], (L, 2, S5_GROUPS, S5_GROUP, S5_STATE), 0.5),
        's5_d': nrm(ks[21], (L, S5_WIDTH), 1.0),
        's5_w_glu': nrm(ks[22], (L, S5_WIDTH, S5_WIDTH), S5_WIDTH ** -0.5),
        's5_b_glu': nrm(ks[23], (L, S5_WIDTH), 0.02),
        'swa_qk_g': gain(ks[24], (L, 2, SWA_HEAD_DIM)),
        'swa_sink': nrm(ks[25], (L, SWA_HEADS), 1.0),
        'w_branch': nrm(ks[26], (L, N_BRANCH, BRANCH_WIDTH, D_MODEL), BRANCH_WIDTH ** -0.5),
        'w_out': nrm(ks[27], (L, D_MODEL, D_MODEL), D_MODEL ** -0.5),
        'ffn_w_in': nrm(ks[28], (L, D_MODEL, 2 * FFN_HIDDEN), D_MODEL ** -0.5),
        'ffn_w_out': nrm(ks[29], (L, FFN_HIDDEN, D_MODEL), FFN_HIDDEN ** -0.5),
    }


def reference(x, c, ctx, c_ctx, w_ada, b_ada, norm1_g, norm2_g, w_in,
              mla_qa_g, mla_kva_g, mla_w_uq, mla_w_ukv, mla_qk_g,
              s5_lambda_re, s5_lambda_im, s5_log_step, s5_b_re, s5_b_im,
              s5_c_re, s5_c_im, s5_d, s5_w_glu, s5_b_glu,
              swa_qk_g, swa_sink, w_branch, w_out, ffn_w_in, ffn_w_out):
    b, n_lat, _ = x.shape
    rows = n_lat // GRID_W
    row = jnp.repeat(jnp.arange(rows, dtype=jnp.float32), GRID_W)
    col = jnp.tile(jnp.arange(GRID_W, dtype=jnp.float32), rows)
    ang_mla = axial_rope_angles(row, col, MLA_ROPE)
    ang_swa = axial_rope_angles(row, col, SWA_HEAD_DIM)
    sc_x = jax.nn.silu(c)
    sc_c = jax.nn.silu(c_ctx)[None]
    h_x, h_c = x, ctx
    for l in range(DEPTH):
        need_ctx_out = l < DEPTH - 1
        sh1x, sc1x, g1x, sh2x, sc2x, g2x = jnp.split(sc_x @ w_ada[l] + b_ada[l], 6, axis=-1)
        sh1c, sc1c, g1c, sh2c, sc2c, g2c = jnp.split(sc_c @ w_ada[l] + b_ada[l], 6, axis=-1)

        hx = modulate(rms_norm(h_x, norm1_g[l]), sh1x, sc1x)
        hc = modulate(rms_norm(h_c, norm1_g[l]), sh1c, sc1c)
        px = jnp.split(hx @ w_in[l], IN_SPLITS, axis=-1)
        pc = jnp.split(hc @ w_in[l], IN_SPLITS, axis=-1)

        mq_x, mk_x, mv_x = mla_project(px[0], px[1], px[2], mla_qa_g[l], mla_kva_g[l],
                                       mla_w_uq[l], mla_w_ukv[l], mla_qk_g[l], ang_mla)
        mq_c, mk_c, mv_c = mla_project(pc[0], pc[1], pc[2], mla_qa_g[l], mla_kva_g[l],
                                       mla_w_uq[l], mla_w_ukv[l], mla_qk_g[l], None)
        k_all = jnp.concatenate([mk_c, mk_x], axis=1)
        v_all = jnp.concatenate([mv_c, mv_x], axis=1)
        mla_x = blocked_dense_attention(mq_x, k_all, v_all)

        a_f, bb_f, cc_f = s5_params(s5_lambda_re[l, 0], s5_lambda_im[l, 0], s5_log_step[l, 0],
                                    s5_b_re[l, 0], s5_b_im[l, 0], s5_c_re[l, 0], s5_c_im[l, 0])
        a_b, bb_b, cc_b = s5_params(s5_lambda_re[l, 1], s5_lambda_im[l, 1], s5_log_step[l, 1],
                                    s5_b_re[l, 1], s5_b_im[l, 1], s5_c_re[l, 1], s5_c_im[l, 1])
        u_x = px[3].astype(jnp.float32).reshape(b, n_lat, S5_GROUPS, S5_GROUP)
        u_c = pc[3].astype(jnp.float32).reshape(b, pc[3].shape[1], S5_GROUPS, S5_GROUP)
        st_cf = s5_scan(u_c, a_f, bb_f, None, False)
        st_cb = s5_scan(u_c, a_b, bb_b, None, True)
        st_xf = s5_scan(u_x, a_f, bb_f, st_cf[:, -1], False)
        st_xb = s5_scan(u_x, a_b, bb_b, st_cb[:, 0], True)
        s5_x = s5_readout(st_xf, st_xb, u_x, cc_f, cc_b, s5_d[l], s5_w_glu[l], s5_b_glu[l], h_x.dtype)

        sq_x, sk_x, sv_x = swa_project(px[4], px[5], swa_qk_g[l], ang_swa)
        sq_c, sk_c, sv_c = swa_project(pc[4], pc[5], swa_qk_g[l], None)
        swa_x = swa_latent(sq_x, sk_x, sv_x, sk_c, sv_c, swa_sink[l])

        mix_x = merge_branches(mla_x, s5_x, swa_x, px[6], w_branch[l], w_out[l])
        h_x = h_x + g1x[:, None] * mix_x
        if need_ctx_out:
            mla_c = full_attention(mq_c, mk_c, mv_c).reshape(b, pc[0].shape[1], MLA_HEADS * MLA_V)
            s5_c = s5_readout(st_cf, st_cb, u_c, cc_f, cc_b, s5_d[l], s5_w_glu[l], s5_b_glu[l], h_c.dtype)
            swa_c = swa_context(sq_c, sk_c, sv_c, swa_sink[l])
            mix_c = merge_branches(mla_c, s5_c, swa_c, pc[6], w_branch[l], w_out[l])
            h_c = h_c + g1c[:, None] * mix_c

        fx = modulate(rms_norm(h_x, norm2_g[l]), sh2x, sc2x)
        h_x = h_x + g2x[:, None] * swiglu(fx, ffn_w_in[l], ffn_w_out[l])
        if need_ctx_out:
            fc = modulate(rms_norm(h_c, norm2_g[l]), sh2c, sc2c)
            h_c = h_c + g2c[:, None] * swiglu(fc, ffn_w_in[l], ffn_w_out[l])
    return h_x
```

```cpp
#include <hip/hip_runtime.h>
#include <hip/hip_cooperative_groups.h>
#include <cstdio>
namespace cg = cooperative_groups;

typedef _Float16 h16;
typedef __attribute__((ext_vector_type(8))) _Float16 h16x8;
typedef __attribute__((ext_vector_type(4))) _Float16 h16x4;
typedef __attribute__((ext_vector_type(16))) float f32x16;
typedef __attribute__((ext_vector_type(4))) unsigned u32x4;

#define DI __device__ __forceinline__

constexpr int NB = 8, SEQ = 4096, CTXL = 256, NTOK = 4352, MTOT = 34816, DM = 1024, FFH = 2816;
constexpr int PXW = 2048;
constexpr int QKVW = 2048;
constexpr int NCH = 136;
constexpr int NCHT = NB * NCH;
constexpr int PX_QD = 0, PX_KVD = 384, PX_U = 640, PX_SQ = 1152, PX_SK = 1664, PX_SV = 1792, PX_KR = 1920;
constexpr int PX_MLAO = 0, PX_S5O = 640, PX_SWAO = 1152;

constexpr size_t WO_IN = 0;
constexpr size_t WO_UQ = WO_IN + (size_t)5120 * 1024;
constexpr size_t WO_UKV = WO_UQ + (size_t)768 * 384;
constexpr size_t WO_GLU = WO_UKV + (size_t)1024 * 256;
constexpr size_t WO_BR = WO_GLU + (size_t)512 * 512;
constexpr size_t WO_OUT = WO_BR + (size_t)3 * 1024 * 512;
constexpr size_t WO_F1 = WO_OUT + (size_t)1024 * 1024;
constexpr size_t WO_F2 = WO_F1 + (size_t)5632 * 1024;
constexpr size_t W16_HALVES = WO_F2 + (size_t)1024 * 2816;

constexpr size_t OFF_W16 = 0;
constexpr size_t OFF_MQ = OFF_W16 + W16_HALVES * 2;
constexpr size_t OFF_P = OFF_MQ + (size_t)32 * 512 * 768 * 2;
constexpr size_t OFF_HX = OFF_P + (size_t)32 * 256 * 512 * 2;
constexpr size_t OFF_PX = OFF_HX + (size_t)MTOT * 1024 * 2;
constexpr size_t OFF_QKV = OFF_PX + (size_t)MTOT * PXW * 2;
constexpr size_t OFF_YACT = OFF_QKV + (size_t)MTOT * QKVW * 2;
constexpr size_t OFF_S = OFF_YACT + (size_t)MTOT * 512 * 2;
constexpr size_t OFF_HIN = OFF_S + (size_t)NCHT * 32 * 256 * 2;
constexpr size_t OFF_CTXH = OFF_HIN + (size_t)NCHT * 32 * 256 * 2;
constexpr size_t OFF_MOD = OFF_CTXH + (size_t)2048 * 1024 * 4;
constexpr size_t OFF_POW = OFF_MOD + (size_t)2 * 9 * 6144 * 4;
constexpr size_t OFF_BB = OFF_POW + (size_t)2 * 32 * 2 * 64 * 33 * 8;
constexpr size_t OFF_LAG = OFF_BB + (size_t)2 * 32 * 2 * 64 * 16 * 8;
constexpr size_t OFF_BAR = OFF_LAG + (size_t)32 * 2 * 32 * 256 * 4;
constexpr size_t WS_NEED = OFF_BAR + 16384;

constexpr int SMEM_BYTES = 131072;
constexpr int DYN_LDS = SMEM_BYTES + 16;
constexpr int NT = 512;
constexpr size_t OFF_GATES = OFF_QKV;
static_assert(OFF_GATES + (size_t)MTOT * 3072 * 2 == OFF_CTXH, "gates region");

struct Params {
  const float* in[30];
  float* out;
  char* ws;
};

enum { I_X = 0, I_C, I_CTX, I_CCTX, I_WADA, I_BADA, I_N1G, I_N2G, I_WIN, I_QAG, I_KVAG, I_WUQ, I_WUKV, I_MQKG,
       I_LRE, I_LIM, I_LSTEP, I_BRE, I_BIM, I_CRE, I_CIM, I_S5D, I_WGLU, I_BGLU, I_SQKG, I_SINK, I_WBR, I_WOUT, I_F1, I_F2 };

typedef const Params __attribute__((address_space(4))) CParams;
__device__ __forceinline__ CParams* launder(CParams* p) { asm volatile("" : "+s"(p)); return p; }

__device__ __forceinline__ int otid() { int t = threadIdx.x; asm volatile("" : "+v"(t)); return t; }
DI float shx(float v, int mask, int lane) { return __builtin_bit_cast(float, __builtin_amdgcn_ds_bpermute((lane ^ mask) << 2, __builtin_bit_cast(int, v))); }
DI float wave_sum_(float v, int lane) {
#pragma unroll
  for (int o = 32; o > 0; o >>= 1) v += shx(v, o, lane);
  return v;
}
#define wave_sum(v) wave_sum_((v), lane)
DI float sigmoidf_(float x) { return __builtin_amdgcn_rcpf(1.f + __builtin_amdgcn_exp2f(-1.4426950408889634f * x)); }
DI float gelu_tanh(float x) { return x * sigmoidf_(1.5957691216057308f * (x + 0.044715f * x * x * x)); }
DI int crow(int i, int h) { return (i & 3) + 8 * (i >> 2) + 4 * h; }

struct RowInfo { int mr; size_t ridx; bool isctx; };
DI RowInfo rowinfo(int row) {
  RowInfo r;
  int b = row / NTOK, pos = row - b * NTOK;
  r.isctx = pos < CTXL;
  r.mr = r.isctx ? 8 : b;
  r.ridx = r.isctx ? (size_t)(b * CTXL + pos) : (size_t)(b * SEQ + pos - CTXL);
  return r;
}

#ifndef REPG
#define REPG 1
#endif
#ifndef REPA
#define REPA 1
#endif
#ifndef PMODE
#define PMODE 7
#endif
template <int NI, int RR, class AF>
DI void gemm_core_(f32x16 (&acc)[2][NI], AF af, const h16* __restrict__ Bt, int ldb, int K, char* smem) {
  const int tid5 = otid();
  const int tid = tid5 & 255, lane = tid & 63, wid = tid >> 6;
  h16* As = (h16*)(smem + (tid5 >> 8) * 36864);
  h16* Bs = As + 128 * 72;
  const int wr = wid >> 1, wc = wid & 1, lr = lane & 31, lh = lane >> 5;
#pragma unroll 1
  for (int rep = 0; rep < RR; ++rep) {
#pragma unroll
  for (int mi = 0; mi < 2; ++mi)
#pragma unroll
    for (int ni = 0; ni < NI; ++ni)
#pragma unroll
      for (int i = 0; i < 16; ++i) acc[mi][ni][i] = 0.f;
  u32x4 ra[4], rb[NI * 2];
#pragma unroll
  for (int i = 0; i < 4; ++i) { int c = tid + 256 * i; ra[i] = *(const u32x4*)af(c >> 3, (c & 7) * 8); }
#pragma unroll
  for (int i = 0; i < NI * 2; ++i) { int c = tid + 256 * i; rb[i] = *(const u32x4*)(Bt + (size_t)(c >> 3) * ldb + (c & 7) * 8); }
  for (int k0 = 0; k0 < K; k0 += 64) {
    __syncthreads();
#pragma unroll
    for (int i = 0; i < 4; ++i) { int c = tid + 256 * i; *(u32x4*)(As + (c >> 3) * 72 + (c & 7) * 8) = ra[i]; }
#pragma unroll
    for (int i = 0; i < NI * 2; ++i) { int c = tid + 256 * i; *(u32x4*)(Bs + (c >> 3) * 72 + (c & 7) * 8) = rb[i]; }
    __syncthreads();
    if (k0 + 64 < K) {
#pragma unroll
      for (int i = 0; i < 4; ++i) { int c = tid + 256 * i; ra[i] = *(const u32x4*)af(c >> 3, k0 + 64 + (c & 7) * 8); }
#pragma unroll
      for (int i = 0; i < NI * 2; ++i) { int c = tid + 256 * i; rb[i] = *(const u32x4*)(Bt + (size_t)(c >> 3) * ldb + k0 + 64 + (c & 7) * 8); }
    }
#pragma unroll
    for (int ks = 0; ks < 4; ++ks) {
      h16x8 a[2], b[NI];
#pragma unroll
      for (int mi = 0; mi < 2; ++mi) a[mi] = *(const h16x8*)(As + (wr * 64 + mi * 32 + lr) * 72 + ks * 16 + lh * 8);
#pragma unroll
      for (int ni = 0; ni < NI; ++ni) b[ni] = *(const h16x8*)(Bs + (wc * NI * 32 + ni * 32 + lr) * 72 + ks * 16 + lh * 8);
#pragma unroll
      for (int mi = 0; mi < 2; ++mi)
#pragma unroll
        for (int ni = 0; ni < NI; ++ni) acc[mi][ni] = __builtin_amdgcn_mfma_f32_32x32x16_f16(a[mi], b[ni], acc[mi][ni], 0, 0, 0);
    }
  }
  }
}
template <int NI, class AF>
DI void gemm_core(f32x16 (&acc)[2][NI], AF af, const h16* __restrict__ Bt, int ldb, int K, char* smem) { gemm_core_<NI, REPG>(acc, af, Bt, ldb, K, smem); }
template <int NI, class AF>
DI void gemm_core1(f32x16 (&acc)[2][NI], AF af, const h16* __restrict__ Bt, int ldb, int K, char* smem) { gemm_core_<NI, 1>(acc, af, Bt, ldb, K, smem); }
template <int NI, class EF>
DI void gemm_epi(f32x16 (&acc)[2][NI], EF ef) {
  const int tid_ = otid(); const int lane = tid_ & 63, wid = (tid_ >> 6) & 3;
  const int wr = wid >> 1, wc = wid & 1, lr = lane & 31, lh = lane >> 5;
#pragma unroll
  for (int mi = 0; mi < 2; ++mi)
#pragma unroll
    for (int ni = 0; ni < NI; ++ni)
#pragma unroll
      for (int i = 0; i < 16; ++i) ef(wr * 64 + mi * 32 + crow(i, lh), wc * NI * 32 + ni * 32 + lr, acc[mi][ni][i]);
}

DI void ph_ada(CParams* PP_, char* smem) {
  CParams& P = *launder(PP_);
  float* sc = (float*)smem;
  float* red = sc + 9 * 1024;
  float* mod = (float*)(P.ws + OFF_MOD);
  const float* cin = P.in[I_C]; const float* cctx = P.in[I_CCTX]; const float* wada = P.in[I_WADA]; const float* bada = P.in[I_BADA];
  const int tid = otid();
  for (int item = (int)gridDim.x - 1 - (int)blockIdx.x; item < 384; item += gridDim.x) {
    const int l = item / 192, n0 = (item % 192) * 32;
    for (int i = tid; i < 9 * 1024; i += NT) {
      int r = i >> 10, k = i & 1023;
      float v = (r < 8) ? cin[r * 1024 + k] : cctx[k];
      sc[i] = v / (1.f + expf(-v));
    }
    __syncthreads();
    const int cx = tid & 31, kg = tid >> 5;
    float acc[9];
#pragma unroll
    for (int r = 0; r < 9; ++r) acc[r] = 0.f;
    const float* w = wada + (size_t)l * 1024 * 6144 + n0 + cx;
#pragma unroll 1
    for (int k0 = kg * 64; k0 < kg * 64 + 64; k0 += 16) {
      float wv[16];
#pragma unroll
      for (int e = 0; e < 16; ++e) wv[e] = w[(size_t)(k0 + e) * 6144];
#pragma unroll
      for (int e = 0; e < 16; ++e)
#pragma unroll
        for (int r = 0; r < 9; ++r) acc[r] += sc[r * 1024 + k0 + e] * wv[e];
    }
#pragma unroll
    for (int r = 0; r < 9; ++r) red[(kg * 9 + r) * 32 + cx] = acc[r];
    __syncthreads();
    for (int i = tid; i < 9 * 32; i += NT) {
      int r = i >> 5, cc = i & 31;
      float v = 0.f;
#pragma unroll
      for (int q = 0; q < 16; ++q) v += red[(q * 9 + r) * 32 + cc];
      mod[(size_t)(l * 9 + r) * 6144 + n0 + cc] = v + bada[l * 6144 + n0 + cc];
    }
    __syncthreads();
  }
}

DI int map_win(int n) {
  if (n < 640) return n;
  if (n < 1152) return 672 + (n - 640);
  if (n < 1664) return 1184 + (n - 1152);
  if (n < 1920) return 1696 + (n - 1664);
  if (n < 1952) return 640 + (n - 1920);
  if (n < 2048) return -1;
  return 1952 + (n - 2048);
}
DI int map_f1(int n) {
  const int t = n >> 8, w = n & 255;
  return (w < 128) ? (t * 128 + w) : (FFH + t * 128 + (w - 128));
}
DI void ph_convert(CParams* PP_, int l, char* smem) {
  CParams& P = *launder(PP_);
  float* tile = (float*)smem;
  h16* W = (h16*)(P.ws + OFF_W16);
  const int tid = otid(), tx = tid & 63, ty = tid >> 6;
  constexpr int C0 = 1280, C1 = C0 + 72, C2 = C1 + 64, C3 = C2 + 64, C4 = C3 + 384, C5 = C4 + 256, C6 = C5 + 1408, C7 = C6 + 704;
  struct TileDesc { const float* src; h16* dst; int K, ldsrc, k0, n0, scol; };
  auto desc = [&](int t) {
    TileDesc d; int nt, id, tt;
    if (t < C0) { id = 0; tt = t; d.src = P.in[I_WIN] + (size_t)l * 1024 * 5024; d.ldsrc = 5024; d.K = 1024; nt = 80; d.dst = W + WO_IN; }
    else if (t < C1) { id = 1; tt = t - C0; d.src = P.in[I_WUQ] + (size_t)l * 384 * 768; d.ldsrc = 768; d.K = 384; nt = 12; d.dst = W + WO_UQ; }
    else if (t < C2) { id = 1; tt = t - C1; d.src = P.in[I_WUKV] + (size_t)l * 256 * 1024; d.ldsrc = 1024; d.K = 256; nt = 16; d.dst = W + WO_UKV; }
    else if (t < C3) { id = 1; tt = t - C2; d.src = P.in[I_WGLU] + (size_t)l * 512 * 512; d.ldsrc = 512; d.K = 512; nt = 8; d.dst = W + WO_GLU; }
    else if (t < C4) { id = 1; tt = t - C3; int r = tt / 128; tt -= r * 128; d.src = P.in[I_WBR] + ((size_t)l * 3 + r) * 512 * 1024; d.ldsrc = 1024; d.K = 512; nt = 16; d.dst = W + WO_BR + (size_t)r * 1024 * 512; }
    else if (t < C5) { id = 1; tt = t - C4; d.src = P.in[I_WOUT] + (size_t)l * 1024 * 1024; d.ldsrc = 1024; d.K = 1024; nt = 16; d.dst = W + WO_OUT; }
    else if (t < C6) { id = 2; tt = t - C5; d.src = P.in[I_F1] + (size_t)l * 1024 * 5632; d.ldsrc = 5632; d.K = 1024; nt = 88; d.dst = W + WO_F1; }
    else { id = 1; tt = t - C6; d.src = P.in[I_F2] + (size_t)l * 2816 * 1024; d.ldsrc = 1024; d.K = 2816; nt = 16; d.dst = W + WO_F2; }
    d.k0 = (tt / nt) * 64; d.n0 = (tt % nt) * 64;
    int scol = d.n0 + tx;
    if (id == 0) scol = map_win(scol);
    else if (id == 2) scol = map_f1(scol);
    d.scol = scol;
    return d;
  };
  float rv[8];
  auto loadt = [&](const TileDesc& d) {
#pragma unroll
    for (int i = 0; i < 8; ++i) rv[i] = (d.scol >= 0) ? d.src[(size_t)(d.k0 + ty + 8 * i) * d.ldsrc + d.scol] : 0.f;
  };
  int t = blockIdx.x;
  if (t < C7) { TileDesc d0 = desc(t); loadt(d0); }
  for (; t < C7; t += gridDim.x) {
    const TileDesc d = desc(t);
#pragma unroll
    for (int i = 0; i < 8; ++i) tile[(ty + 8 * i) * 65 + tx] = rv[i];
    __syncthreads();
    if (t + (int)gridDim.x < C7) { const TileDesc dn = desc(t + gridDim.x); loadt(dn); }
#pragma unroll
    for (int i = 0; i < 8; ++i) { const int nn = ty + 8 * i; d.dst[(size_t)(d.n0 + nn) * d.K + d.k0 + tx] = (h16)tile[tx * 65 + nn]; }
    __syncthreads();
  }
}

DI void ph_s5pow(CParams* PP_) {
  CParams& P = *launder(PP_);
  const int t = blockIdx.x * NT + otid();
  if (t >= 8192) return;
  const int p = t & 63, dir = (t >> 6) & 1, g = (t >> 7) & 31, l = t >> 12;
  const size_t gi = ((size_t)(l * 2 + dir) * 32 + g);
  double lr = (double)P.in[I_LRE][gi * 64 + p]; if (lr > -1e-4) lr = -1e-4;
  const double li = (double)P.in[I_LIM][gi * 64 + p];
  const double dt = exp((double)P.in[I_LSTEP][gi]);
  const double mag = exp(lr * dt);
  double sn, cs; sincos(li * dt, &sn, &cs);
  const double ar = mag * cs, ai = mag * sn;
  float2* pw = (float2*)(P.ws + OFF_POW) + (size_t)l * (32 * 2 * 64 * 33) + ((size_t)(g * 2 + dir) * 64 + p) * 33;
  double pr = 1.0, pi = 0.0;
  for (int k = 0; k < 33; ++k) {
    pw[k] = make_float2((float)pr, (float)pi);
    double nr = pr * ar - pi * ai, ni = pr * ai + pi * ar; pr = nr; pi = ni;
  }
  const double den = lr * lr + li * li;
  const double cr = ((ar - 1.0) * lr + ai * li) / den, ci = (ai * lr - (ar - 1.0) * li) / den;
  float2* bb = (float2*)(P.ws + OFF_BB) + (size_t)l * (32 * 2 * 64 * 16) + ((size_t)(g * 2 + dir) * 64 + p) * 16;
  for (int j = 0; j < 16; ++j) {
    double br = (double)P.in[I_BRE][(gi * 64 + p) * 16 + j], bi = (double)P.in[I_BIM][(gi * 64 + p) * 16 + j];
    bb[j] = make_float2((float)(cr * br - ci * bi), (float)(cr * bi + ci * br));
  }
}
DI void ph_s5lag(CParams* PP_, int l, char* smem) {
  CParams& P = *launder(PP_);
  const float2* pw = (const float2*)(P.ws + OFF_POW) + (size_t)l * (32 * 2 * 64 * 33);
  const float2* bb = (const float2*)(P.ws + OFF_BB) + (size_t)l * (32 * 2 * 64 * 16);
  float* lag = (float*)(P.ws + OFF_LAG);
  const float* cre_g = P.in[I_CRE]; const float* cim_g = P.in[I_CIM];
  float2* pwS = (float2*)smem;
  float2* bbS = pwS + 64 * 8;
  float2* cS = bbS + 64 * 16;
  const int tid = otid();
  unsigned* qctr = (unsigned*)(P.ws + OFF_BAR) + 3650 + l;
  volatile __attribute__((address_space(3))) unsigned* qslot = (volatile __attribute__((address_space(3))) unsigned*)(smem + SMEM_BYTES + 8);
  for (;;) {
    __syncthreads();
    if (tid == 0) *qslot = __hip_atomic_fetch_add(qctr, 1u, __ATOMIC_RELAXED, __HIP_MEMORY_SCOPE_AGENT);
    __syncthreads();
    const int item = (int)*qslot;
    if (item >= 256) break;
    const int kq = item & 3, dir = (item >> 2) & 1, g = item >> 3;
    const size_t gi = ((size_t)(l * 2 + dir) * 32 + g);
    const size_t gb = (size_t)(g * 2 + dir) * 64;
    for (int i = tid; i < 512; i += NT) { int p = i >> 3, k = i & 7; pwS[i] = pw[(gb + p) * 33 + kq * 8 + k]; }
    for (int i = tid; i < 1024; i += NT) bbS[i] = bb[gb * 16 + i];
    for (int i = tid; i < 1024; i += NT) cS[i] = make_float2(cre_g[gi * 1024 + i], cim_g[gi * 1024 + i]);
    __syncthreads();
    const int kh = tid >> 8, i = (tid >> 4) & 15, j = tid & 15;
    float sm[4];
#pragma unroll
    for (int k = 0; k < 4; ++k) sm[k] = 0.f;
#pragma unroll 4
    for (int p = 0; p < 64; ++p) {
      const float2 c = cS[i * 64 + p]; const float2 b = bbS[p * 16 + j];
      const float cbr = c.x * b.x - c.y * b.y, cbi = c.x * b.y + c.y * b.x;
#pragma unroll
      for (int k = 0; k < 4; ++k) { const float2 a = pwS[p * 8 + kh * 4 + k]; sm[k] += cbr * a.x - cbi * a.y; }
    }
#pragma unroll
    for (int k = 0; k < 4; ++k) lag[(((size_t)(g * 2 + dir) * 32 + kq * 8 + kh * 4 + k) * 16 + i) * 16 + j] = sm[k];
    __syncthreads();
  }
}

DI void ph_s5mats(CParams* PP_, int l) {
  CParams& P = *launder(PP_);
  const float2* pw = (const float2*)(P.ws + OFF_POW) + (size_t)l * (32 * 2 * 64 * 33);
  const float2* bb = (const float2*)(P.ws + OFF_BB) + (size_t)l * (32 * 2 * 64 * 16);
  const float* lag = (const float*)(P.ws + OFF_LAG);
  h16* MQ = (h16*)(P.ws + OFF_MQ);
  h16* PM = (h16*)(P.ws + OFF_P);
  const float* cre_g = P.in[I_CRE]; const float* cim_g = P.in[I_CIM]; const float* s5d = P.in[I_S5D];
  const int NMQ = 32 * 512 * 96, NPM = 32 * 256 * 64;
  for (int t = blockIdx.x * NT + otid(); t < NMQ + NPM; t += gridDim.x * NT) {
    h16x8 o;
    if (t < NMQ) {
      const int g = t / (512 * 96); int rem = t - g * (512 * 96);
      const int n = rem / 96, k8 = (rem - n * 96) * 8;
      const int tt = n >> 4, i = n & 15;
      if (k8 < 512) {
        const int s = k8 >> 4, j0 = k8 & 15;
        const float* lf = lag + ((size_t)(g * 2 + 0) * 32) * 256 + i * 16 + j0;
        const float* lb = lag + ((size_t)(g * 2 + 1) * 32) * 256 + i * 16 + j0;
        float v[8];
        if (s < tt) { const float4 a = *(const float4*)(lf + (tt - s) * 256), b = *(const float4*)(lf + (tt - s) * 256 + 4); v[0]=a.x;v[1]=a.y;v[2]=a.z;v[3]=a.w;v[4]=b.x;v[5]=b.y;v[6]=b.z;v[7]=b.w; }
        else if (s > tt) { const float4 a = *(const float4*)(lb + (s - tt) * 256), b = *(const float4*)(lb + (s - tt) * 256 + 4); v[0]=a.x;v[1]=a.y;v[2]=a.z;v[3]=a.w;v[4]=b.x;v[5]=b.y;v[6]=b.z;v[7]=b.w; }
        else {
          const float4 a = *(const float4*)(lf), b = *(const float4*)(lf + 4), c = *(const float4*)(lb), d = *(const float4*)(lb + 4);
          v[0]=a.x+c.x;v[1]=a.y+c.y;v[2]=a.z+c.z;v[3]=a.w+c.w;v[4]=b.x+d.x;v[5]=b.y+d.y;v[6]=b.z+d.z;v[7]=b.w+d.w;
          const float dd = s5d[l * 512 + g * 16 + i];
#pragma unroll
          for (int e = 0; e < 8; ++e) if (j0 + e == i) v[e] += dd;
        }
#pragma unroll
        for (int e = 0; e < 8; ++e) o[e] = (h16)v[e];
      } else {
        const int kk = k8 - 512, dir = kk >> 7, p0 = (kk >> 1) & 63;
        const int ex = dir ? (32 - tt) : (tt + 1);
        const size_t gi = ((size_t)(l * 2 + dir) * 32 + g);
#pragma unroll
        for (int q = 0; q < 4; ++q) {
          const float cr = cre_g[(gi * 16 + i) * 64 + p0 + q], ci = cim_g[(gi * 16 + i) * 64 + p0 + q];
          const float2 a = pw[((size_t)(g * 2 + dir) * 64 + p0 + q) * 33 + ex];
          o[2 * q] = (h16)(cr * a.x - ci * a.y);
          o[2 * q + 1] = (h16)(-(cr * a.y + ci * a.x));
        }
      }
      *(h16x8*)(MQ + (size_t)t * 8) = o;
    } else {
      const int u = t - NMQ;
      const int g = u / (256 * 64); int rem = u - g * (256 * 64);
      const int n = rem >> 6, k8 = (rem & 63) * 8;
      const int dir = n >> 7, p = (n >> 1) & 63, c = n & 1;
      const int s = k8 >> 4, j0 = k8 & 15;
      const int ex = dir ? s : (31 - s);
      const float2 a = pw[((size_t)(g * 2 + dir) * 64 + p) * 33 + ex];
      const float2* bp = bb + ((size_t)(g * 2 + dir) * 64 + p) * 16 + j0;
#pragma unroll
      for (int e = 0; e < 8; ++e) { const float2 b = bp[e]; o[e] = (h16)(c ? (a.x * b.y + a.y * b.x) : (a.x * b.x - a.y * b.y)); }
      *(h16x8*)(PM + (size_t)u * 8) = o;
    }
  }
}

DI void ph_s5scan(CParams* PP_, int l) {
  CParams& P = *launder(PP_);
  const int tid_s = otid();
  if (tid_s < 384) return;
#pragma unroll 1
  for (int t = blockIdx.x * 128 + (tid_s - 384); t < 32768; t += gridDim.x * 128) {
  const int p = t & 63, dir = (t >> 6) & 1, g = (t >> 7) & 31, b = t >> 12;
  const float2 a32 = ((const float2*)(P.ws + OFF_POW))[(size_t)l * (32 * 2 * 64 * 33) + ((size_t)(g * 2 + dir) * 64 + p) * 33 + 32];
  const h16* S = (const h16*)(P.ws + OFF_S);
  h16* H = (h16*)(P.ws + OFF_HIN);
  float hr = 0.f, hi = 0.f;
  typedef __attribute__((ext_vector_type(2))) _Float16 h16x2_t;
  auto cidx = [&](int it) {
    const int c = (dir == 0) ? it : ((it < 8) ? (7 - it) : (NCH - 1 - (it - 8)));
    return ((size_t)(b * NCH + c) * 32 + g) * 256 + dir * 128 + p * 2;
  };
  unsigned raw[8], nraw[8];
#pragma unroll
  for (int e = 0; e < 8; ++e) raw[e] = *(const unsigned*)(S + cidx(e));
#pragma unroll 1
  for (int it0 = 0; it0 < NCH; it0 += 8) {
    if (it0 + 8 < NCH) {
#pragma unroll
      for (int e = 0; e < 8; ++e) nraw[e] = *(const unsigned*)(S + cidx(it0 + 8 + e));
    }
#pragma unroll
    for (int e = 0; e < 8; ++e) {
      const h16x2_t sv = __builtin_bit_cast(h16x2_t, raw[e]);
      h16x2_t hv; hv[0] = (h16)hr; hv[1] = (h16)hi;
      *(unsigned*)(H + cidx(it0 + e)) = __builtin_bit_cast(unsigned, hv);
      const float nr = a32.x * hr - a32.y * hi + (float)sv[0], ni = a32.x * hi + a32.y * hr + (float)sv[1];
      hr = nr; hi = ni;
    }
#pragma unroll
    for (int e = 0; e < 8; ++e) raw[e] = nraw[e];
  }
  }
}

DI void ph_norm(CParams* PP_, int l, int which) {
  CParams& P = *launder(PP_);
  const int tid_ = otid(); const int lane = tid_ & 63, wid = tid_ >> 6;
  h16* hx = (h16*)(P.ws + OFF_HX);
  const float* mod = (const float*)(P.ws + OFF_MOD);
  const float* gsrc = P.in[which ? I_N2G : I_N1G] + l * 1024;
  const bool from_in = (l == 0 && which == 0);
  const float* src_c = from_in ? P.in[I_CTX] : (const float*)(P.ws + OFF_CTXH);
  const float* src_x = from_in ? P.in[I_X] : (const float*)P.out;
  float4 g4[4];
#pragma unroll
  for (int i = 0; i < 4; ++i) g4[i] = *(const float4*)(gsrc + i * 256 + lane * 4);
  const int stride = gridDim.x * 8;
  int row = blockIdx.x * 8 + wid;
  float4 v[4], nv[4];
  if (row < MTOT) {
    const RowInfo ri = rowinfo(row);
    const float* src = (ri.isctx ? src_c : src_x) + ri.ridx * 1024;
#pragma unroll
    for (int i = 0; i < 4; ++i) v[i] = *(const float4*)(src + i * 256 + lane * 4);
  }
  for (; row < MTOT; row += stride) {
    const RowInfo ri = rowinfo(row);
    const float* sh = mod + (size_t)(l * 9 + ri.mr) * 6144 + (which ? 3 : 0) * 1024;
    const float* scl = sh + 1024;
    if (row + stride < MTOT) {
      const RowInfo rn = rowinfo(row + stride);
      const float* srcn = (rn.isctx ? src_c : src_x) + rn.ridx * 1024;
#pragma unroll
      for (int i = 0; i < 4; ++i) nv[i] = *(const float4*)(srcn + i * 256 + lane * 4);
    }
    float4 s1[4], s0[4];
#pragma unroll
    for (int i = 0; i < 4; ++i) { s1[i] = *(const float4*)(scl + i * 256 + lane * 4); s0[i] = *(const float4*)(sh + i * 256 + lane * 4); }
    float ss = 0.f;
#pragma unroll
    for (int i = 0; i < 4; ++i) ss += v[i].x * v[i].x + v[i].y * v[i].y + v[i].z * v[i].z + v[i].w * v[i].w;
    ss = wave_sum(ss);
    const float rstd = rsqrtf(ss * (1.f / 1024.f) + 1e-6f);
#pragma unroll
    for (int i = 0; i < 4; ++i) {
      const int c = i * 256 + lane * 4;
      h16x4 o;
      o[0] = (h16)(v[i].x * rstd * g4[i].x * (1.f + s1[i].x) + s0[i].x);
      o[1] = (h16)(v[i].y * rstd * g4[i].y * (1.f + s1[i].y) + s0[i].y);
      o[2] = (h16)(v[i].z * rstd * g4[i].z * (1.f + s1[i].z) + s0[i].z);
      o[3] = (h16)(v[i].w * rstd * g4[i].w * (1.f + s1[i].w) + s0[i].w);
      *(h16x4*)(hx + (size_t)row * 1024 + c) = o;
    }
#pragma unroll
    for (int i = 0; i < 4; ++i) v[i] = nv[i];
  }
}
DI void ph_prep(CParams* PP_, int l) {
  CParams& P = *launder(PP_);
  const int tid_ = otid(); const int lane = tid_ & 63, wid = tid_ >> 6;
  h16* px = (h16*)(P.ws + OFF_PX);
  const float* qag = P.in[I_QAG] + l * 384;
  const float* kvag = P.in[I_KVAG] + l * 256;
  const float* sqg = P.in[I_SQKG] + l * 128;
  const int aidx = lane & 31;
  const float freq = exp2f(-(float)(aidx & 15) * (13.287712379549449f / 16.f));
  float gq6[6], gkv4[4];
#pragma unroll
  for (int i = 0; i < 6; ++i) gq6[i] = qag[i * 64 + lane];
#pragma unroll
  for (int i = 0; i < 4; ++i) gkv4[i] = kvag[i * 64 + lane];
  const float gsq = sqg[lane], gsk = sqg[64 + lane];
  const int stride = gridDim.x * 8;
  h16 rq[6], rkv[4], rh[10];
  auto loadrow = [&](int r) {
    const h16* p = px + (size_t)r * PXW;
#pragma unroll
    for (int i = 0; i < 6; ++i) rq[i] = p[PX_QD + i * 64 + lane];
#pragma unroll
    for (int i = 0; i < 4; ++i) rkv[i] = p[PX_KVD + i * 64 + lane];
#pragma unroll
    for (int hh = 0; hh < 10; ++hh) rh[hh] = p[PX_SQ + hh * 64 + lane];
  };
  if (blockIdx.x * 8 + wid < MTOT) loadrow(blockIdx.x * 8 + wid);
  for (int row = blockIdx.x * 8 + wid; row < MTOT; row += stride) {
    h16* pr = px + (size_t)row * PXW;
    const int b = row / NTOK, pos = row - b * NTOK;
    const bool lat = pos >= CTXL;
    const int tpos = pos - CTXL;
    float vq[6], vkv[4], vh[10];
#pragma unroll
    for (int i = 0; i < 6; ++i) vq[i] = (float)rq[i];
#pragma unroll
    for (int i = 0; i < 4; ++i) vkv[i] = (float)rkv[i];
#pragma unroll
    for (int hh = 0; hh < 10; ++hh) vh[hh] = (float)rh[hh];
    if (row + stride < MTOT) loadrow(row + stride);
    float cs = 1.f, sn = 0.f;
    if (lat) { const float ang = (float)((aidx < 16) ? (tpos >> 6) : (tpos & 63)) * freq; sincosf(ang, &sn, &cs); }
    float ssq = 0.f, sskv = 0.f;
#pragma unroll
    for (int i = 0; i < 6; ++i) ssq += vq[i] * vq[i];
#pragma unroll
    for (int i = 0; i < 4; ++i) sskv += vkv[i] * vkv[i];
    float ssh[10];
#pragma unroll
    for (int hh = 0; hh < 10; ++hh) ssh[hh] = vh[hh] * vh[hh];
#pragma unroll
    for (int o = 32; o > 0; o >>= 1) {
      const float t0 = shx(ssq, o, lane), t1 = shx(sskv, o, lane);
      float tt[10];
#pragma unroll
      for (int hh = 0; hh < 10; ++hh) tt[hh] = shx(ssh[hh], o, lane);
      ssq += t0; sskv += t1;
#pragma unroll
      for (int hh = 0; hh < 10; ++hh) ssh[hh] += tt[hh];
    }
    const float rq = rsqrtf(ssq * (1.f / 384.f) + 1e-6f), rkv = rsqrtf(sskv * (1.f / 256.f) + 1e-6f);
#pragma unroll
    for (int i = 0; i < 6; ++i) pr[PX_QD + i * 64 + lane] = (h16)(vq[i] * rq * gq6[i]);
#pragma unroll
    for (int i = 0; i < 4; ++i) pr[PX_KVD + i * 64 + lane] = (h16)(vkv[i] * rkv * gkv4[i]);
#pragma unroll
    for (int hh = 0; hh < 10; ++hh) {
      const float rstd = rsqrtf(ssh[hh] * (1.f / 64.f) + 1e-6f);
      const float vn = vh[hh] * rstd * ((hh < 8) ? gsq : gsk);
      const float partner = shx(vn, 32, lane);
      const float o = (lane < 32) ? (vn * cs - partner * sn) : (vn * cs + partner * sn);
      pr[PX_SQ + hh * 64 + lane] = (h16)o;
    }
  }
}

DI void ph_final(CParams* PP_, int l) {
  CParams& P = *launder(PP_);
  const int tid_ = otid(); const int lane = tid_ & 63, wid = tid_ >> 6;
  h16* qkv = (h16*)(P.ws + OFF_QKV);
  const h16* px = (const h16*)(P.ws + OFF_PX);
  const float* gq = P.in[I_MQKG] + l * 192;
  const float* gk = gq + 96;
  const int aidx = lane & 15;
  const float freq = exp2f(-(float)(aidx & 7) * (13.287712379549449f / 8.f));
  const float gq0 = gq[lane], gk0 = gk[lane];
  const float gq1 = (lane < 32) ? gq[64 + lane] : 0.f, gk1 = (lane < 32) ? gk[64 + lane] : 0.f;
  const int stride = gridDim.x * 6;
  h16 r0[16], r1[8], rk;
  auto loadrow = [&](int r) {
    const h16* q = qkv + (size_t)r * QKVW;
    rk = (lane < 32) ? px[(size_t)r * PXW + PX_KR + lane] : (h16)0.f;
#pragma unroll
    for (int hh = 0; hh < 16; ++hh) r0[hh] = q[hh * 96 + lane];
#pragma unroll
    for (int hh = 0; hh < 8; ++hh) r1[hh] = (lane < 32) ? q[hh * 96 + 64 + lane] : (h16)0.f;
  };
  if (wid < 6 && blockIdx.x * 6 + wid < MTOT) loadrow(blockIdx.x * 6 + wid);
  for (int row = (wid < 6) ? (int)(blockIdx.x * 6 + wid) : MTOT; row < MTOT; row += stride) {
    h16* qr = qkv + (size_t)row * QKVW;
    const int b = row / NTOK, pos = row - b * NTOK;
    const bool lat = pos >= CTXL;
    const int tpos = pos - CTXL;
    float v0[16], v1[8];
    const float kpe = (float)rk;
#pragma unroll
    for (int hh = 0; hh < 16; ++hh) v0[hh] = (float)r0[hh];
#pragma unroll
    for (int hh = 0; hh < 8; ++hh) v1[hh] = (float)r1[hh];
    if (row + stride < MTOT) loadrow(row + stride);
    float cs = 1.f, sn = 0.f;
    if (lat) { const float ang = (float)((aidx < 8) ? (tpos >> 6) : (tpos & 63)) * freq; sincosf(ang, &sn, &cs); }
    float ss[16];
#pragma unroll
    for (int hh = 0; hh < 16; ++hh) { const float w1 = (hh < 8) ? v1[hh] : kpe; ss[hh] = v0[hh] * v0[hh] + w1 * w1; }
#pragma unroll
    for (int o = 32; o > 0; o >>= 1) {
      float tt[16];
#pragma unroll
      for (int hh = 0; hh < 16; ++hh) tt[hh] = shx(ss[hh], o, lane);
#pragma unroll
      for (int hh = 0; hh < 16; ++hh) ss[hh] += tt[hh];
    }
#pragma unroll
    for (int hh = 0; hh < 16; ++hh) {
      const bool isk = hh >= 8;
      const float rstd = rsqrtf(ss[hh] * (1.f / 96.f) + 1e-6f);
      const float o0 = v0[hh] * rstd * (isk ? gk0 : gq0);
      const float w1 = isk ? kpe : v1[hh & 7];
      const float v1n = w1 * rstd * (isk ? gk1 : gq1);
      const float partner = shx(v1n, 16, lane);
      const float o1 = ((lane & 16) == 0) ? (v1n * cs - partner * sn) : (v1n * cs + partner * sn);
      qr[hh * 96 + lane] = (h16)o0;
      if (lane < 32) qr[hh * 96 + 64 + lane] = (h16)o1;
    }
  }
}

template <int DQK>
DI void attn_block(const h16* __restrict__ Q, int ldq, const h16* __restrict__ Kb, int ldk,
                           const h16* __restrict__ Vb, int ldv, h16* __restrict__ O, int ldo,
                           int ntiles, int na, int t0b, int qpos0, const float* sinkv, bool has_sink, float scale_l2, char* smem, bool gqa = false) {
  constexpr int KS = DQK + 8;
  constexpr int NKCH = 64 * (DQK / 8);
  constexpr int NKC = (NKCH + NT - 1) / NT;
  constexpr int CPK = DQK / 8;
  constexpr int VS = 96;
  constexpr int HB = 64 * KS + 64 * VS;
  typedef short v4s_t __attribute__((__vector_size__(4 * sizeof(short))));
  h16* const buf0 = (h16*)smem;
  const int tid = otid(), lane = tid & 63, wid = tid >> 6, lr = lane & 31, lh = lane >> 5;
  const int qrow_w = gqa ? ((wid & 1) * 32) : (wid * 32);
  const int qcol_w = gqa ? ((wid >> 1) * 64) : 0;
  const float sink_l2 = has_sink ? sinkv[gqa ? (wid >> 1) : 0] * 1.4426950408889634f : 0.f;
  h16x8 qf[DQK / 16];
  {
    const h16* qp = Q + (size_t)(qrow_w + lr) * ldq + qcol_w + lh * 8;
#pragma unroll
    for (int ks = 0; ks < DQK / 16; ++ks) qf[ks] = *(const h16x8*)(qp + ks * 16);
  }
  f32x16 o[2];
  float m, lsum;
  u32x4 kreg[NKC], vreg[1];
#pragma unroll 1
  for (int rep = 0; rep < REPA; ++rep) {
#pragma unroll
  for (int d = 0; d < 2; ++d)
#pragma unroll
    for (int i = 0; i < 16; ++i) o[d][i] = 0.f;
  m = has_sink ? sink_l2 : -1e30f;
  lsum = (has_sink && lh == 0) ? 1.f : 0.f;
  const bool full = (rep == REPA - 1);
  const bool do_qk = full || (PMODE & 1), do_sm = full || (PMODE & 2), do_pv = full || (PMODE & 4);
  auto load_tile = [&](int it) {
    const int kp0 = ((it < na) ? it : (t0b + (it - na))) * 64;
#pragma unroll
    for (int i = 0; i < NKC; ++i) { int c = tid + NT * i; if (c < NKCH) { int key = c / CPK, dc = c - key * CPK; kreg[i] = *(const u32x4*)(Kb + (size_t)(kp0 + key) * ldk + dc * 8); } }
    { int key = tid >> 3, dvc = tid & 7; vreg[0] = *(const u32x4*)(Vb + (size_t)(kp0 + key) * ldv + dvc * 8); }
  };
  auto store_tile = [&](h16* Ksd) {
    h16* Vtd = Ksd + 64 * KS;
#pragma unroll
    for (int i = 0; i < NKC; ++i) { int c = tid + NT * i; if (c < NKCH) { int key = c / CPK, dc = c - key * CPK; *(u32x4*)(Ksd + key * KS + dc * 8) = kreg[i]; } }
    { int key = tid >> 3, dvc = tid & 7; *(u32x4*)(Vtd + key * VS + dvc * 8) = vreg[0]; }
  };
  auto qk = [&](f32x16 (&sd)[2], const h16* Ksrc) {
    h16x8 kf[2][DQK / 16];
#pragma unroll
    for (int ks = 0; ks < DQK / 16; ++ks)
#pragma unroll
      for (int kt = 0; kt < 2; ++kt) kf[kt][ks] = *(const h16x8*)(Ksrc + (kt * 32 + lr) * KS + ks * 16 + lh * 8);
    const f32x16 zv = {0.f, 0.f, 0.f, 0.f, 0.f, 0.f, 0.f, 0.f, 0.f, 0.f, 0.f, 0.f, 0.f, 0.f, 0.f, 0.f};
#pragma unroll
    for (int kt = 0; kt < 2; ++kt) sd[kt] = __builtin_amdgcn_mfma_f32_32x32x16_f16(kf[kt][0], qf[0], zv, 0, 0, 0);
#pragma unroll
    for (int ks = 1; ks < DQK / 16; ++ks)
#pragma unroll
      for (int kt = 0; kt < 2; ++kt) sd[kt] = __builtin_amdgcn_mfma_f32_32x32x16_f16(kf[kt][ks], qf[ks], sd[kt], 0, 0, 0);
  };
  load_tile(0);
  store_tile(buf0);
  if (ntiles > 1) { load_tile(1); store_tile(buf0 + HB); }
  __syncthreads();
  if (ntiles > 2) load_tile(2);
  f32x16 s[2], sn[2];
#pragma unroll
  for (int kt = 0; kt < 2; ++kt)
#pragma unroll
    for (int i = 0; i < 16; ++i) { s[kt][i] = 0.f; sn[kt][i] = 0.f; }
  const int wid_u = __builtin_amdgcn_readfirstlane(wid);
  auto tclass = [&](int it) -> int {
    if (it < na) return 1;
    const int klo = (t0b + (it - na)) * 64 - CTXL, khi = klo + 63;
    const int qlo = qpos0 + (gqa ? ((wid_u & 1) * 32) : (wid_u * 32)), qhi = qlo + 31;
    if (khi < qlo - 128 || klo > qhi + 128) return 0;
    if (klo >= qhi - 128 && khi <= qlo + 128) return 1;
    return 2;
  };
  int bcur = 0;
#pragma unroll 1
  for (int it = 0; it < ntiles; ++it) {
    const int bnext = (bcur == 2) ? 0 : bcur + 1;
    const int bfree = (bnext == 2) ? 0 : bnext + 1;
    const h16* Vt = buf0 + bcur * HB + 64 * KS;
    const int cls = tclass(it);
    if (cls != 0) {
    qk(s, buf0 + bcur * HB);
    h16x8 vfr[2][2][2];
    if (do_pv) {
#pragma unroll
      for (int kt = 0; kt < 2; ++kt)
#pragma unroll
        for (int st = 0; st < 2; ++st)
#pragma unroll
          for (int d = 0; d < 2; ++d) {
            const h16* vp = Vt + (kt * 32 + st * 16 + 4 * lh + ((lane >> 2) & 3)) * VS + d * 32 + 16 * ((lane >> 4) & 1) + 4 * (lane & 3);
            const v4s_t lo = __builtin_amdgcn_ds_read_tr16_b64_v4i16((__attribute__((address_space(3))) v4s_t*)vp);
            const v4s_t hi = __builtin_amdgcn_ds_read_tr16_b64_v4i16((__attribute__((address_space(3))) v4s_t*)(vp + 8 * VS));
            vfr[kt][st][d] = __builtin_bit_cast(h16x8, __builtin_shufflevector(lo, hi, 0, 1, 2, 3, 4, 5, 6, 7));
          }
    }
    if (do_sm) {
    if (cls == 2) {
      const int kl0 = (t0b + (it - na)) * 64 - CTXL;
      const int qp = qpos0 + qrow_w + lr;
      const int dq = qp - kl0 - 4 * lh;
#pragma unroll
      for (int kt = 0; kt < 2; ++kt)
#pragma unroll
        for (int i = 0; i < 16; ++i) { const int d = dq - (kt * 32 + (i & 3) + 8 * (i >> 2)); if (d > 128 || d < -128) s[kt][i] = -3.0e38f; }
    }
    float mx = -3.0e38f;
#pragma unroll
    for (int kt = 0; kt < 2; ++kt)
#pragma unroll
      for (int i = 0; i < 16; ++i) mx = fmaxf(mx, s[kt][i]);
    if (__builtin_amdgcn_ballot_w64(mx * scale_l2 > m + 8.f) != 0ull) {
      mx = fmaxf(mx, shx(mx, 32, lane));
      const float mn = fmaxf(m, mx * scale_l2);
      const float alpha = __builtin_amdgcn_exp2f(m - mn);
      m = mn;
      lsum *= alpha;
#pragma unroll
      for (int d = 0; d < 2; ++d)
#pragma unroll
        for (int i = 0; i < 16; ++i) o[d][i] *= alpha;
    }
    typedef float f32x2_t __attribute__((ext_vector_type(2)));
    f32x2_t ps2 = {0.f, 0.f};
    const f32x2_t sc2 = {scale_l2, scale_l2}, nm2 = {-m, -m};
#pragma unroll
    for (int kt = 0; kt < 2; ++kt)
#pragma unroll
      for (int i = 0; i < 16; i += 2) {
        f32x2_t t = {s[kt][i], s[kt][i + 1]};
        t = t * sc2 + nm2;
        f32x2_t pv; pv.x = __builtin_amdgcn_exp2f(t.x); pv.y = __builtin_amdgcn_exp2f(t.y);
        s[kt][i] = pv.x; s[kt][i + 1] = pv.y; ps2 += pv;
      }
    lsum += ps2.x + ps2.y;
    }
    if (do_pv) {
#pragma unroll
    for (int kt = 0; kt < 2; ++kt)
#pragma unroll
      for (int st = 0; st < 2; ++st) {
        h16x8 pf;
#pragma unroll
        for (int j = 0; j < 8; ++j) pf[j] = (h16)s[kt][8 * st + j];
#pragma unroll
        for (int d = 0; d < 2; ++d) {
          const h16x8 va = vfr[kt][st][d];
          o[d] = __builtin_amdgcn_mfma_f32_32x32x16_f16(va, pf, o[d], 0, 0, 0);
        }
      }
    }
    }
    if (it + 2 < ntiles) store_tile(buf0 + bfree * HB);
    __syncthreads();
    if (it + 3 < ntiles) load_tile(it + 3);
    bcur = bnext;
  }
  if (!full) {
#pragma unroll
    for (int d = 0; d < 2; ++d)
#pragma unroll
      for (int i = 0; i < 16; ++i) { asm volatile("" :: "v"(o[d][i])); asm volatile("" :: "v"(s[d][i])); }
    asm volatile("" :: "v"(lsum), "v"(m));
  }
  }
  const float lt = lsum + shx(lsum, 32, lane);
  const float inv = 1.f / lt;
  h16* op = O + (size_t)(qrow_w + lr) * ldo + qcol_w;
#pragma unroll
  for (int d = 0; d < 2; ++d)
#pragma unroll
    for (int g4 = 0; g4 < 4; ++g4) {
      h16x4 w;
#pragma unroll
      for (int j = 0; j < 4; ++j) w[j] = (h16)(o[d][g4 * 4 + j] * inv);
      *(h16x4*)(op + d * 32 + g4 * 8 + lh * 4) = w;
    }
  __syncthreads();
}

#define XB_TMO      128
#define XB_XCNT(j)  (256  + 64 * (j))
#define XB_XSUB(j)  (1280 + 64 * (j))
#define XB_XGEN(j)  (2304 + 64 * (j))
#define XB_TOP      3328
#define XB_TOPGEN   3392
#define XCD_BAR_WORDS 3456
#define XB_SPIN_CAP (1u << 20)
#define LAS __attribute__((address_space(3)))
DI unsigned xb_ld(unsigned* p)              { return __hip_atomic_load(p, __ATOMIC_RELAXED, __HIP_MEMORY_SCOPE_AGENT); }
DI unsigned xb_add(unsigned* p, unsigned v) { return __hip_atomic_fetch_add(p, v, __ATOMIC_RELAXED, __HIP_MEMORY_SCOPE_AGENT); }
DI unsigned xb_xcc_id() { return (unsigned)__builtin_amdgcn_s_getreg((3 << 11) | 20) & 0xFu; }
#define XB_SPIN(cond, bar) do { unsigned _sp = 0; while (cond) { __builtin_amdgcn_s_sleep(1); \
    if ((++_sp & 255u) == 0u) { if (xb_ld(&(bar)[XB_TMO])) break; if (_sp > XB_SPIN_CAP) { atomicAdd(&(bar)[XB_TMO], 1u); break; } } } } while (0)
struct XcdBarrier { unsigned* bar; unsigned x; volatile LAS unsigned* st; };
DI XcdBarrier xcd_barrier_post(unsigned* bar, volatile LAS unsigned* st) {
  XcdBarrier b; b.bar = bar; b.x = xb_xcc_id(); b.st = st;
  if (threadIdx.x == 0) (void)xb_add(&bar[XB_XCNT(b.x)], 1u);
  return b;
}
DI void xcd_barrier_complete(unsigned* bar, unsigned x, unsigned& nloc, unsigned& nx) {
  const unsigned G = gridDim.x * gridDim.y * gridDim.z;
  unsigned sum, cnt, mine, sp = 0u;
  for (;;) {
    sum = 0u; cnt = 0u; mine = 0u;
#pragma unroll
    for (unsigned j = 0; j < 16; ++j) { const unsigned c = xb_ld(&bar[XB_XCNT(j)]); sum += c; cnt += (c > 0u) ? 1u : 0u; mine = (j == x) ? c : mine; }
    if (sum == G) break;
    __builtin_amdgcn_s_sleep(1);
    if ((++sp & 255u) == 0u) { if (xb_ld(&bar[XB_TMO])) break; if (sp > XB_SPIN_CAP) { atomicAdd(&bar[XB_TMO], 1u); break; } }
  }
  nloc = mine > 0u ? mine : 1u; nx = cnt > 0u ? cnt : 1u;
}
DI void xcd_barrier(CParams* PP_, volatile LAS unsigned* st) {
  XcdBarrier b; b.bar = (unsigned*)(launder(PP_)->ws + OFF_BAR); b.x = xb_xcc_id(); b.st = st;
  asm volatile("s_waitcnt vmcnt(0)" ::: "memory");
  __syncthreads();
  if (threadIdx.x == 0) {
    unsigned* bar = b.bar;
    __builtin_amdgcn_s_waitcnt(0);
    unsigned nloc = b.st[0], nx = b.st[1];
    if (nloc == 0u) { xcd_barrier_complete(bar, b.x, nloc, nx); b.st[0] = nloc; b.st[1] = nx; }
    const unsigned old = xb_add(&bar[XB_XSUB(b.x)], 1u);
    const unsigned gen = old / nloc;
    if (old + 1u == (gen + 1u) * nloc) {
      __builtin_amdgcn_fence(__ATOMIC_RELEASE, "agent");
      asm volatile("s_waitcnt vmcnt(0)" ::: "memory");
      const unsigned og = xb_add(&bar[XB_TOP], 1u);
      const unsigned tg = og / nx;
      if (og + 1u == (tg + 1u) * nx) xb_add(&bar[XB_TOPGEN], 1u);
      else XB_SPIN(xb_ld(&bar[XB_TOPGEN]) == tg, bar);
      __builtin_amdgcn_fence(__ATOMIC_ACQUIRE, "agent");
      xb_add(&bar[XB_XGEN(b.x)], 1u);
      asm volatile("s_waitcnt vmcnt(0)" ::: "memory");
    } else {
      XB_SPIN(xb_ld(&bar[XB_XGEN(b.x)]) == gen, bar);
      __builtin_amdgcn_fence(__ATOMIC_ACQUIRE, "agent");
      asm volatile("s_waitcnt vmcnt(0)" ::: "memory");
    }
  }
  __syncthreads();
}

namespace pg8 {
constexpr int BM = 256, BK = 64, HALF = 128, HTB = HALF * BK * 2, NXCD = 8, WGM = 8;
DI int lds_byte(int r, int c) { const int st = (r >> 4) * 2 + (c >> 5), rr = r & 15, cc = c & 31, ob = rr * 64 + cc * 2; return st * 1024 + (ob ^ (((ob >> 9) & 1) << 5)); }
DI void stage_rc(int b, int& R, int& C) { const int st = b / 1024, sb = b % 1024, swz = sb ^ (((sb >> 9) & 1) << 5); R = (st >> 1) * 16 + swz / 64; C = (st & 1) * 32 + (swz % 64) / 2; }
DI int perm32(int rho) { const int n = rho >> 4, i = rho & 15; return 8 * (i >> 2) + 4 * n + (i & 3); }
struct Unit { int pm, pn, seg; };
DI bool next_unit(int i, int G, int c, int nM, int nN, bool lat, int nseg, Unit& u) {
  if (lat) nM = 128;
  const int nwg = nM * nN;
  const int ib = i / nseg; u.seg = i - ib * nseg;
  const long L = (long)ib * G + c; if (L >= nwg) return false;
  int wgid = (int)L; { const int q = nwg / NXCD, r = nwg % NXCD, xcd = wgid % NXCD, off = wgid / NXCD; wgid = (xcd < r ? xcd * (q + 1) : r * (q + 1) + (xcd - r) * q) + off; }
  const int nig = WGM * nN, gid = wgid / nig, fm = gid * WGM, gsz = (nM - fm) < WGM ? (nM - fm) : WGM;
  u.pm = fm + ((wgid % nig) % gsz); u.pn = (wgid % nig) / gsz;
  if (lat) u.pm = u.pm + (u.pm >> 4) + 1;
  return true;
}
typedef float f32x4 __attribute__((ext_vector_type(4)));

template <bool PERM, class Epi>
DI void gemm_fast(LAS unsigned char* lds, const h16* A, int lda, const h16* Bt, int K, int nM, int nN, const Epi& E, bool lat = false,
                   int nseg = 1, int segA0 = 0, int segA1 = 0, int segA2 = 0, size_t segB = 0) {
  const int tid = otid(), wid = __builtin_amdgcn_readfirstlane(tid >> 6), lane = tid & 63, wr = wid >> 2, wc = wid & 3, fr = lane & 15, fq = lane >> 4;
  const int nt = K / BK;
  const int G = gridDim.x, cblk = blockIdx.x;
  unsigned voffA[2], voffB[2];
#pragma unroll
  for (int i = 0; i < 2; ++i) { int R, C; stage_rc(tid * 16 + i * 8192, R, C); const int Rb = PERM ? ((R & ~31) + perm32(R & 31)) : R;
    voffA[i] = (unsigned)(R * lda + C) * 2u; voffB[i] = (unsigned)(Rb * K + C) * 2u; }
  const size_t kstep = (size_t)(BK * 2);
  const size_t hstepA = (size_t)HALF * lda * 2, hstepB = (size_t)HALF * K * 2;
  const size_t tstepA = 2 * hstepA, tstepB = 2 * hstepB;
  const unsigned ldsw = (unsigned)wid * 1024u;
  const int aoff = lds_byte(wr * 64 + fr, fq * 8), boff = lds_byte(wc * 32 + fr, fq * 8);
#define PG8_SA(b, h) (((b) * 2 + (h)) * HTB)
#define PG8_SB(b, h) ((4 + (b) * 2 + (h)) * HTB)
#define PG8_STAGE(bufoff, gbase, voff) do { _Pragma("unroll") for (int _i = 0; _i < 2; ++_i) \
    __builtin_amdgcn_global_load_lds((const unsigned*)((const char*)(gbase) + (voff)[_i]), (LAS unsigned*)(lds + (bufoff) + ldsw + _i * 8192), 16, 0, 0); } while (0)
#define PG8_LDA(dst, b, h) do { _Pragma("unroll") for (int m = 0; m < 4; ++m) _Pragma("unroll") for (int k = 0; k < 2; ++k) dst[m][k] = *(const LAS h16x8*)(lds + PG8_SA(b, h) + aoff + m * 2048 + k * 1024); } while (0)
#define PG8_LDB(dst, b, h) do { _Pragma("unroll") for (int n = 0; n < 2; ++n) _Pragma("unroll") for (int k = 0; k < 2; ++k) dst[n][k] = *(const LAS h16x8*)(lds + PG8_SB(b, h) + boff + n * 2048 + k * 1024); } while (0)
#define PG8_MMA(ai, bj, At, Bt_) do { __builtin_amdgcn_s_setprio(1); _Pragma("unroll") for (int m = 0; m < 4; ++m) _Pragma("unroll") for (int n = 0; n < 2; ++n) _Pragma("unroll") for (int k = 0; k < 2; ++k) \
    acc[ai][bj][m][n] = __builtin_amdgcn_mfma_f32_16x16x32_f16(Bt_[n][k], At[m][k], acc[ai][bj][m][n], 0, 0, 0); __builtin_amdgcn_s_setprio(0); } while (0)
#define PG8_WAIT_V(n) asm volatile("s_waitcnt vmcnt(" #n ")" ::: "memory")
#define PG8_WAIT_L(n) asm volatile("s_waitcnt lgkmcnt(" #n ")" ::: "memory")
#define PG8_BAR __builtin_amdgcn_s_barrier()
#define PG8_SCHED __builtin_amdgcn_sched_barrier(0)
  Unit cur, nxt; int ui = 0;
  if (!next_unit(0, G, cblk, nM, nN, lat, nseg, cur)) return;
  auto sa = [&](int sg) { return (size_t)(sg == 0 ? segA0 : (sg == 1 ? segA1 : segA2)); };
  f32x4 acc[2][2][4][2];
#pragma unroll
  for (int a = 0; a < 2; ++a)
#pragma unroll
    for (int b = 0; b < 2; ++b)
#pragma unroll
      for (int m = 0; m < 4; ++m)
#pragma unroll
        for (int n = 0; n < 2; ++n) acc[a][b][m][n] = (f32x4){0.f, 0.f, 0.f, 0.f};
  h16x8 At[4][2], B0[2][2], B1[2][2];
  const char* cA = (const char*)A + sa(cur.seg) + (size_t)cur.pm * tstepA; const char* cB = (const char*)Bt + cur.seg * segB + (size_t)cur.pn * tstepB;
  PG8_STAGE(PG8_SB(0, 0), cB, voffB); PG8_STAGE(PG8_SA(0, 0), cA, voffA); PG8_STAGE(PG8_SB(0, 1), cB + hstepB, voffB); PG8_STAGE(PG8_SA(0, 1), cA + hstepA, voffA);
  if (wr == 1) PG8_BAR;
  PG8_WAIT_V(4); PG8_BAR;
  PG8_STAGE(PG8_SB(1, 0), cB + kstep, voffB); PG8_STAGE(PG8_SA(1, 0), cA + kstep, voffA); PG8_STAGE(PG8_SB(1, 1), cB + hstepB + kstep, voffB);
  PG8_WAIT_V(6); PG8_BAR;
  for (;;) {
    const bool has_next = next_unit(ui + 1, G, cblk, nM, nN, lat, nseg, nxt);
    const char* nA = has_next ? (const char*)A + sa(nxt.seg) + (size_t)nxt.pm * tstepA : cA; const char* nB = has_next ? (const char*)Bt + nxt.seg * segB + (size_t)nxt.pn * tstepB : cB;
    for (int t = 0; t < nt; t += 2) {
      const bool last = (t == nt - 2);
      const char* a1 = cA + (size_t)(t + 1) * kstep;
      const char* a2 = last ? nA : cA + (size_t)(t + 2) * kstep; const char* b2 = last ? nB : cB + (size_t)(t + 2) * kstep;
      const char* a3 = a2 + kstep; const char* b3 = b2 + kstep;
      PG8_LDB(B0, 0, 0); PG8_SCHED; PG8_LDA(At, 0, 0); PG8_STAGE(PG8_SA(1, 1), a1 + hstepA, voffA);
      PG8_WAIT_L(8); PG8_BAR; PG8_WAIT_L(0); PG8_MMA(0, 0, At, B0); PG8_BAR; PG8_SCHED;
      PG8_LDB(B1, 0, 1); PG8_STAGE(PG8_SB(0, 0), b2, voffB);
      PG8_BAR; PG8_WAIT_L(0); PG8_MMA(0, 1, At, B1); PG8_BAR;
      PG8_LDA(At, 0, 1); PG8_STAGE(PG8_SA(0, 0), a2, voffA);
      PG8_BAR; PG8_WAIT_L(0); PG8_MMA(1, 0, At, B0); PG8_BAR; PG8_SCHED;
      PG8_STAGE(PG8_SB(0, 1), b2 + hstepB, voffB);
      PG8_WAIT_V(6); PG8_BAR; PG8_MMA(1, 1, At, B1); PG8_BAR;
      PG8_LDB(B0, 1, 0); PG8_SCHED; PG8_LDA(At, 1, 0); PG8_STAGE(PG8_SA(0, 1), a2 + hstepA, voffA);
      PG8_WAIT_L(8); PG8_BAR; PG8_WAIT_L(0); PG8_MMA(0, 0, At, B0); PG8_BAR; PG8_SCHED;
      PG8_LDB(B1, 1, 1); PG8_STAGE(PG8_SB(1, 0), b3, voffB);
      PG8_BAR; PG8_WAIT_L(0); PG8_MMA(0, 1, At, B1); PG8_BAR;
      PG8_LDA(At, 1, 1); PG8_STAGE(PG8_SA(1, 0), a3, voffA);
      PG8_BAR; PG8_WAIT_L(0); PG8_MMA(1, 0, At, B0); PG8_BAR; PG8_SCHED;
      PG8_STAGE(PG8_SB(1, 1), b3 + hstepB, voffB);
      PG8_WAIT_V(6); PG8_BAR; PG8_MMA(1, 1, At, B1); PG8_BAR;
    }
    { const int et = otid(); const int ew = et >> 6, el = et & 63; E(acc, cur, ew >> 2, ew & 3, el & 15, el >> 4); }
    if (!has_next) break;
#pragma unroll
    for (int a = 0; a < 2; ++a)
#pragma unroll
      for (int b = 0; b < 2; ++b)
#pragma unroll
        for (int m = 0; m < 4; ++m)
#pragma unroll
          for (int n = 0; n < 2; ++n) acc[a][b][m][n] = (f32x4){0.f, 0.f, 0.f, 0.f};
    cur = nxt; cA = nA; cB = nB; ++ui;
  }
  PG8_WAIT_V(0);
  if (wr == 0) PG8_BAR;
  PG8_BAR;
#undef PG8_SA
#undef PG8_SB
#undef PG8_STAGE
#undef PG8_LDA
#undef PG8_LDB
#undef PG8_MMA
#undef PG8_WAIT_V
#undef PG8_WAIT_L
#undef PG8_BAR
#undef PG8_SCHED
}
template <class F>
DI void epi8(const f32x4 (&acc)[2][2][4][2], const Unit& u, int wr, int wc, int fr, int fq, F fn) {
#pragma unroll
  for (int ai = 0; ai < 2; ++ai)
#pragma unroll
    for (int m = 0; m < 4; ++m) {
      const int row = u.pm * BM + ai * HALF + wr * 64 + m * 16 + fr;
#pragma unroll
      for (int bj = 0; bj < 2; ++bj) fn(row, u.pn * BM + bj * HALF + wc * 32 + 8 * fq, acc[ai][bj][m][0], acc[ai][bj][m][1]);
    }
}
DI h16x8 pack8(f32x4 lo, f32x4 hi) { h16x8 o; o[0] = (h16)lo[0]; o[1] = (h16)lo[1]; o[2] = (h16)lo[2]; o[3] = (h16)lo[3]; o[4] = (h16)hi[0]; o[5] = (h16)hi[1]; o[6] = (h16)hi[2]; o[7] = (h16)hi[3]; return o; }
}
using pg8::f32x4;

DI void ph_gemm_in(CParams* PP_, char* smem) {
  CParams& P = *launder(PP_);
  const h16* hx = (const h16*)(P.ws + OFF_HX);
  const h16* W = (const h16*)(P.ws + OFF_W16) + WO_IN;
  h16* px = (h16*)(P.ws + OFF_PX);
  auto E = [=](const f32x4 (&acc)[2][2][4][2], const pg8::Unit& u, int wr, int wc, int fr, int fq) {
    pg8::epi8(acc, u, wr, wc, fr, fq, [=](int row, int col, f32x4 lo, f32x4 hi) { *(h16x8*)(px + (size_t)row * PXW + col) = pg8::pack8(lo, hi); });
  };
  pg8::gemm_fast<true>((LAS unsigned char*)smem, hx, 1024, W, 1024, 136, 8, E);
}
DI void ph_upproj(CParams* PP_, int l, char* smem) {
  CParams& P = *launder(PP_);
  const h16* W = (const h16*)(P.ws + OFF_W16);
  h16* px = (h16*)(P.ws + OFF_PX);
  h16* qkv = (h16*)(P.ws + OFF_QKV);
  h16* S = (h16*)(P.ws + OFF_S);
  const h16* PM = (const h16*)(P.ws + OFF_P);
  {
    auto E = [=](const f32x4 (&acc)[2][2][4][2], const pg8::Unit& u, int wr, int wc, int fr, int fq) {
      pg8::epi8(acc, u, wr, wc, fr, fq, [=](int row, int col, f32x4 lo, f32x4 hi) { *(h16x8*)(qkv + (size_t)row * QKVW + col) = pg8::pack8(lo, hi); });
    };
    pg8::gemm_fast<true>((LAS unsigned char*)smem, px + PX_QD, PXW, W + WO_UQ, 384, 136, 3, E);
  }
  {
    auto E = [=](const f32x4 (&acc)[2][2][4][2], const pg8::Unit& u, int wr, int wc, int fr, int fq) {
      pg8::epi8(acc, u, wr, wc, fr, fq, [=](int row, int n, f32x4 lo, f32x4 hi) {
        const int hh = n >> 7, e = n & 127;
        const int col = (e < 64) ? (768 + hh * 96 + e) : (1536 + hh * 64 + (e - 64));
        *(h16x8*)(qkv + (size_t)row * QKVW + col) = pg8::pack8(lo, hi);
      });
    };
    pg8::gemm_fast<true>((LAS unsigned char*)smem, px + PX_KVD, PXW, W + WO_UKV, 256, 136, 4, E);
  }
  __syncthreads();
  const int tid = otid();
  const int half = tid >> 8;
  unsigned* qctr = (unsigned*)(P.ws + OFF_BAR) + 3610 + l;
  volatile LAS unsigned* qslot = (volatile LAS unsigned*)(smem + SMEM_BYTES + 8);
  for (;;) {
    __syncthreads();
    if (tid == 0) *qslot = __hip_atomic_fetch_add(qctr, 1u, __ATOMIC_RELAXED, __HIP_MEMORY_SCOPE_AGENT);
    __syncthreads();
    const int pr = (int)*qslot;
    if (pr >= 288) break;
    const int tt = pr * 2 + half; const int g = tt / 18; const int r2 = tt % 18; const int m0 = (r2 >> 1) * 128, n0 = (r2 & 1) * 128;
    f32x16 acc[2][2];
    gemm_core<2>(acc, [=](int r, int k) { int cc = m0 + r; if (cc > NCHT - 1) cc = NCHT - 1; return px + (size_t)(cc * 32 + (k >> 4)) * PXW + PX_U + g * 16 + (k & 15); },
                 PM + ((size_t)g * 256 + n0) * 512, 512, 512, smem);
    gemm_epi<2>(acc, [=](int r, int c, float v) { const int cc = m0 + r; if (cc < NCHT) S[((size_t)cc * 32 + g) * 256 + n0 + c] = (h16)v; });
  }
  __syncthreads();
}
DI void ph_mix(CParams* PP_, int l, char* smem) {
  CParams& P = *launder(PP_);
  h16* px = (h16*)(P.ws + OFF_PX);
  const h16* qkv = (const h16*)(P.ws + OFF_QKV);
  const h16* MQ = (const h16*)(P.ws + OFF_MQ);
  const h16* HIN = (const h16*)(P.ws + OFF_HIN);
  h16* yact = (h16*)(P.ws + OFF_YACT);
  const float* sinkp = P.in[I_SINK];
  const float L2E = 1.4426950408889634f;
  constexpr int NA = NB * 8 * 17;
  auto run_mla = [&](int h, int b, int qt) {
    const size_t row0 = (size_t)b * NTOK + qt * 256;
    const size_t brow = (size_t)b * NTOK;
    const int ntiles = (qt < 1) ? 4 : 68;
    attn_block<96>(qkv + row0 * QKVW + h * 96, QKVW, qkv + brow * QKVW + 768 + h * 96, QKVW, qkv + brow * QKVW + 1536 + h * 64, QKVW,
                   px + row0 * PXW + PX_MLAO + h * 64, PXW, ntiles, ntiles, 0, 0, nullptr, false, 0.10206207261596577f * L2E, smem);
  };
  for (int t = blockIdx.x; t < 1024; t += gridDim.x) {
    const int r = t >> 8, blk = t & 255, xcd = blk & 7, slot = blk >> 3;
    const int pair = r * 16 + xcd * 2 + (slot >> 4);
    run_mla(pair & 7, pair >> 3, 1 + (slot & 15));
  }
  unsigned* qctr = (unsigned*)(P.ws + OFF_BAR) + 3600 + l;
  volatile LAS unsigned* qslot = (volatile LAS unsigned*)(smem + SMEM_BYTES + 8);
  const int tid = otid();
  const int half = tid >> 8;
  constexpr int QTOT = NA + 576 + 64;
  for (;;) {
    __syncthreads();
    if (tid == 0) *qslot = __hip_atomic_fetch_add(qctr, 1u, __ATOMIC_RELAXED, __HIP_MEMORY_SCOPE_AGENT);
    __syncthreads();
    const int q0 = (int)*qslot;
    if (q0 >= QTOT) break;
    const int q = (q0 < 576) ? (NA + q0) : ((q0 < 576 + NA) ? (q0 - 576) : q0);
    if (q < NA) {
      const int u = q; const int kvh = u & 1, b = (u >> 1) & 7, pb = 67 - (u >> 4);
      const size_t row0 = (size_t)b * NTOK + pb * 64;
      const size_t brow = (size_t)b * NTOK;
      int ntiles = 4, t0b = 0, qpos0 = 0;
      if (pb >= 4) {
        const int start = (pb - 4) * 64;
        const int lo = (start - 128 < 0) ? 0 : (start - 128);
        const int hi = (start + 192 > SEQ) ? SEQ : (start + 192);
        t0b = (CTXL + lo) >> 6; ntiles = 4 + ((hi - lo) >> 6); qpos0 = start;
      }
      attn_block<64>(px + row0 * PXW + PX_SQ + kvh * 256, PXW, px + brow * PXW + PX_SK + kvh * 64, PXW, px + brow * PXW + PX_SV + kvh * 64, PXW,
                     px + row0 * PXW + PX_SWAO + kvh * 256, PXW, ntiles, 4, t0b, qpos0, sinkp + l * 8 + kvh * 4, true, 0.125f * L2E, smem, true);
    } else if (q < NA + 576) {
      const int pr = q - NA;
      const int tt = pr * 2 + half; const int g = tt / 36; const int r2 = tt % 36; const int m0 = (r2 >> 2) * 128, n0 = (r2 & 3) * 128;
      f32x16 acc[2][2];
      gemm_core1<2>(acc, [=](int r, int k) {
        int cc = m0 + r; if (cc > NCHT - 1) cc = NCHT - 1;
        return (k < 512) ? (px + (size_t)(cc * 32 + (k >> 4)) * PXW + PX_U + g * 16 + (k & 15)) : (HIN + ((size_t)cc * 32 + g) * 256 + (k - 512));
      }, MQ + ((size_t)g * 512 + n0) * 768, 768, 768, smem);
      gemm_epi<2>(acc, [=](int r, int c, float v) {
        const int cc = m0 + r; const int n = n0 + c;
        if (cc < NCHT) yact[(size_t)(cc * 32 + (n >> 4)) * 512 + g * 16 + (n & 15)] = (h16)gelu_tanh(v);
      });
    } else {
      const int u = q - NA - 576;
      run_mla(u & 7, u >> 3, 0);
    }
  }
  __syncthreads();
}
DI void ph_glu(CParams* PP_, int l, char* smem) {
  CParams& P = *launder(PP_);
  const h16* W = (const h16*)(P.ws + OFF_W16) + WO_GLU;
  const h16* yact = (const h16*)(P.ws + OFF_YACT);
  h16* px = (h16*)(P.ws + OFF_PX);
  const float* bg = P.in[I_BGLU] + l * 512;
  auto E = [=](const f32x4 (&acc)[2][2][4][2], const pg8::Unit& u, int wr, int wc, int fr, int fq) {
    const int colb = u.pn * 256 + wc * 32 + 8 * fq;
    f32x4 b0[2], b1[2];
#pragma unroll
    for (int bj = 0; bj < 2; ++bj) { b0[bj] = *(const f32x4*)(bg + colb + bj * 128); b1[bj] = *(const f32x4*)(bg + colb + bj * 128 + 4); }
#pragma unroll
    for (int ai = 0; ai < 2; ++ai) {
      h16x8 y[4][2];
#pragma unroll
      for (int m = 0; m < 4; ++m)
#pragma unroll
        for (int bj = 0; bj < 2; ++bj) y[m][bj] = *(const h16x8*)(yact + (size_t)(u.pm * 256 + ai * 128 + wr * 64 + m * 16 + fr) * 512 + colb + bj * 128);
      asm volatile("" ::: "memory");
#pragma unroll
      for (int m = 0; m < 4; ++m)
#pragma unroll
        for (int bj = 0; bj < 2; ++bj) {
          const f32x4 lo = acc[ai][bj][m][0], hi = acc[ai][bj][m][1];
          h16x8 o;
#pragma unroll
          for (int e = 0; e < 4; ++e) { o[e] = (h16)((float)y[m][bj][e] * sigmoidf_(lo[e] + b0[bj][e])); o[4 + e] = (h16)((float)y[m][bj][4 + e] * sigmoidf_(hi[e] + b1[bj][e])); }
          *(h16x8*)(px + (size_t)(u.pm * 256 + ai * 128 + wr * 64 + m * 16 + fr) * PXW + PX_S5O + colb + bj * 128) = o;
        }
    }
  };
  pg8::gemm_fast<true>((LAS unsigned char*)smem, yact, 512, W, 512, 136, 2, E, l == 1);
}
DI void ph_gates(CParams* PP_, int l, char* smem) {
  CParams& P = *launder(PP_);
  const h16* hx = (const h16*)(P.ws + OFF_HX);
  const h16* W = (const h16*)(P.ws + OFF_W16) + WO_IN + (size_t)2048 * 1024;
  h16* gt = (h16*)(P.ws + OFF_GATES);
  auto E = [=](const f32x4 (&acc)[2][2][4][2], const pg8::Unit& u, int wr, int wc, int fr, int fq) {
    pg8::epi8(acc, u, wr, wc, fr, fq, [=](int row, int col, f32x4 lo, f32x4 hi) {
      h16x8 o;
#pragma unroll
      for (int e = 0; e < 4; ++e) { o[e] = (h16)sigmoidf_(lo[e]); o[4 + e] = (h16)sigmoidf_(hi[e]); }
      *(h16x8*)(gt + (size_t)row * 3072 + col) = o;
    });
  };
  pg8::gemm_fast<true>((LAS unsigned char*)smem, hx, 1024, W, 1024, 136, 12, E, l == 1);
}
DI void ph_merge(CParams* PP_, int l, char* smem) {
  CParams& P = *launder(PP_);
  const h16* W = (const h16*)(P.ws + OFF_W16) + WO_BR;
  const h16* px = (const h16*)(P.ws + OFF_PX);
  const h16* gt = (const h16*)(P.ws + OFF_GATES);
  h16* mg = (h16*)(P.ws + OFF_HX);
  {
    auto E = [=](const f32x4 (&acc)[2][2][4][2], const pg8::Unit& u, int wr, int wc, int fr, int fq) {
      const int r3 = u.seg;
      const int colb = u.pn * 256 + wc * 32 + 8 * fq;
#pragma unroll
      for (int ai = 0; ai < 2; ++ai) {
        h16x8 g[4][2], prev[4][2];
#pragma unroll
        for (int m = 0; m < 4; ++m)
#pragma unroll
          for (int bj = 0; bj < 2; ++bj) {
            const size_t row = (size_t)(u.pm * 256 + ai * 128 + wr * 64 + m * 16 + fr);
            g[m][bj] = *(const h16x8*)(gt + row * 3072 + r3 * 1024 + colb + bj * 128);
            if (r3 > 0) prev[m][bj] = *(const h16x8*)(mg + row * 1024 + colb + bj * 128);
          }
        asm volatile("" ::: "memory");
#pragma unroll
        for (int m = 0; m < 4; ++m)
#pragma unroll
          for (int bj = 0; bj < 2; ++bj) {
            const size_t row = (size_t)(u.pm * 256 + ai * 128 + wr * 64 + m * 16 + fr);
            const f32x4 lo = acc[ai][bj][m][0], hi = acc[ai][bj][m][1];
            h16x8 o;
#pragma unroll
            for (int e = 0; e < 4; ++e) {
              float a = (float)g[m][bj][e] * lo[e], bb2 = (float)g[m][bj][4 + e] * hi[e];
              if (r3 > 0) { a += (float)prev[m][bj][e]; bb2 += (float)prev[m][bj][4 + e]; }
              o[e] = (h16)a; o[4 + e] = (h16)bb2;
            }
            *(h16x8*)(mg + row * 1024 + colb + bj * 128) = o;
          }
      }
    };
    pg8::gemm_fast<true>((LAS unsigned char*)smem, px, PXW, W, 512, 136, 4, E, l == 1, 3, PX_MLAO * 2, PX_S5O * 2, PX_SWAO * 2, (size_t)1024 * 512 * 2);
  }
}
DI void ph_resid(CParams* PP_, int l, size_t a_off, int K, size_t w_off, int gate_idx, bool fi_mode, char* smem) {
  CParams& P = *launder(PP_);
  int ll = l; asm volatile("" : "+s"(ll));
  const bool from_in = fi_mode && (ll == 0);
  const h16* A = (const h16*)(P.ws + a_off);
  const h16* Wt = (const h16*)(P.ws + OFF_W16) + w_off;
  const float* mod = (const float*)(P.ws + OFF_MOD) + (size_t)l * 9 * 6144 + gate_idx * 1024;
  float* ctxh = (float*)(P.ws + OFF_CTXH);
  float* outp = P.out;
  const float* src_c = from_in ? P.in[I_CTX] : (const float*)ctxh;
  const float* src_x = from_in ? P.in[I_X] : (const float*)outp;
  auto E = [=](const f32x4 (&acc)[2][2][4][2], const pg8::Unit& u, int wr, int wc, int fr, int fq) {
    const int b = u.pm / 17, jt = u.pm - b * 17;
    const bool isctx = (jt == 0);
    const size_t rbase = isctx ? (size_t)b * CTXL : ((size_t)b * SEQ + (size_t)(jt - 1) * 256);
    const float* src = (isctx ? src_c : src_x) + rbase * 1024;
    float* dst = (isctx ? ctxh : outp) + rbase * 1024;
    const float* gm = mod + (size_t)(isctx ? 8 : b) * 6144;
    const int colb = u.pn * 256 + wc * 32 + 4 * fq;
    f32x4 g[2][2];
#pragma unroll
    for (int bj = 0; bj < 2; ++bj)
#pragma unroll
      for (int n = 0; n < 2; ++n) g[bj][n] = *(const f32x4*)(gm + colb + bj * 128 + 16 * n);
#pragma unroll
    for (int ai = 0; ai < 2; ++ai) {
      f32x4 s0[4][2][2];
#pragma unroll
      for (int m = 0; m < 4; ++m)
#pragma unroll
        for (int bj = 0; bj < 2; ++bj)
#pragma unroll
          for (int n = 0; n < 2; ++n) s0[m][bj][n] = *(const f32x4*)(src + (size_t)(ai * 128 + wr * 64 + m * 16 + fr) * 1024 + colb + bj * 128 + 16 * n);
      asm volatile("" ::: "memory");
#pragma unroll
      for (int m = 0; m < 4; ++m)
#pragma unroll
        for (int bj = 0; bj < 2; ++bj)
#pragma unroll
          for (int n = 0; n < 2; ++n) *(f32x4*)(dst + (size_t)(ai * 128 + wr * 64 + m * 16 + fr) * 1024 + colb + bj * 128 + 16 * n) = s0[m][bj][n] + g[bj][n] * acc[ai][bj][m][n];
    }
  };
  pg8::gemm_fast<false>((LAS unsigned char*)smem, A, K, Wt, K, 136, 4, E, ll == 1);
}
DI void ph_ffn1(CParams* PP_, int l, char* smem) {
  CParams& P = *launder(PP_);
  const h16* hx = (const h16*)(P.ws + OFF_HX);
  const h16* W = (const h16*)(P.ws + OFF_W16) + WO_F1;
  h16* hid = (h16*)(P.ws + OFF_PX);
  auto E = [=](const f32x4 (&acc)[2][2][4][2], const pg8::Unit& u, int wr, int wc, int fr, int fq) {
#pragma unroll
    for (int ai = 0; ai < 2; ++ai)
#pragma unroll
      for (int m = 0; m < 4; ++m) {
        const int row = u.pm * 256 + ai * 128 + wr * 64 + m * 16 + fr;
        const int j0 = u.pn * 128 + wc * 32 + 8 * fq;
        h16x8 o;
#pragma unroll
        for (int n = 0; n < 2; ++n)
#pragma unroll
          for (int e = 0; e < 4; ++e) { const float a = acc[ai][0][m][n][e], g = acc[ai][1][m][n][e]; o[4 * n + e] = (h16)(a * sigmoidf_(a) * g); }
        *(h16x8*)(hid + (size_t)row * FFH + j0) = o;
      }
  };
  pg8::gemm_fast<true>((LAS unsigned char*)smem, hx, 1024, W, 1024, 136, 22, E, l == 1);
}

__global__ void __launch_bounds__(512, 2) fwd_mega(Params Pk) {
  CParams* P = (CParams*)__builtin_amdgcn_kernarg_segment_ptr();
  cg::grid_group grid = cg::this_grid();
  extern __shared__ __attribute__((aligned(16))) char smem[];
  volatile LAS unsigned* xst = (volatile LAS unsigned*)(smem + SMEM_BYTES);
  if (threadIdx.x == 0) { xst[0] = 0u; xst[1] = 0u; }
  __syncthreads();
  (void)xcd_barrier_post((unsigned*)(launder(P)->ws + OFF_BAR), xst);
  if (P->ws == nullptr) grid.sync();
  ph_ada(P, smem);
  ph_convert(P, 0, smem);
  ph_s5pow(P);
  xcd_barrier(P, xst);
  for (int l = 0; l < 2; ++l) {
    ph_norm(P, l, 0);
    if (l == 1) ph_convert(P, 1, smem);
    xcd_barrier(P, xst);
    ph_gemm_in(P, smem);
    ph_s5lag(P, l, smem);
    xcd_barrier(P, xst);
    ph_prep(P, l);
    ph_s5mats(P, l);
    xcd_barrier(P, xst);
    ph_upproj(P, l, smem);
    xcd_barrier(P, xst);
    ph_final(P, l);
    ph_s5scan(P, l);
    xcd_barrier(P, xst);
    ph_mix(P, l, smem);
    xcd_barrier(P, xst);
    ph_glu(P, l, smem);
    xcd_barrier(P, xst);
    ph_gates(P, l, smem);
    xcd_barrier(P, xst);
    ph_merge(P, l, smem);
    xcd_barrier(P, xst);
    ph_resid(P, l, OFF_HX, 1024, WO_OUT, 2, true, smem);
    xcd_barrier(P, xst);
    ph_norm(P, l, 1);
    xcd_barrier(P, xst);
    ph_ffn1(P, l, smem);
    xcd_barrier(P, xst);
    ph_resid(P, l, OFF_PX, FFH, WO_F2, 5, false, smem);
    xcd_barrier(P, xst);
  }
}

extern "C" void kernel_launch(void* const* d_in, const int* in_sizes, int n_in,
                              void* d_out, int out_size, void* d_ws, size_t ws_size,
                              hipStream_t stream) {
  static int grid_blocks = 0;
  if (!grid_blocks) {
    int dev = 0, cus = 0, per_cu = 0;
    (void)hipGetDevice(&dev);
    (void)hipDeviceGetAttribute(&cus, hipDeviceAttributeMultiprocessorCount, dev);
    (void)hipFuncSetAttribute((const void*)fwd_mega, hipFuncAttributeMaxDynamicSharedMemorySize, DYN_LDS);
    (void)hipOccupancyMaxActiveBlocksPerMultiprocessor(&per_cu, fwd_mega, NT, DYN_LDS);
    (void)hipGetLastError();
    grid_blocks = cus;
  }
  if (ws_size < WS_NEED || n_in != 30) { fprintf(stderr, "kernel_launch: ws too small (%zu < %zu) or n_in %d\n", ws_size, (size_t)WS_NEED, n_in); return; }
  (void)hipMemsetAsync((char*)d_ws + OFF_BAR, 0, 16384, stream);
  Params p{};
  for (int i = 0; i < 30; ++i) p.in[i] = (const float*)d_in[i];
  p.out = (float*)d_out;
  p.ws = (char*)d_ws;
  void* args[] = {&p};
  hipError_t e = hipLaunchCooperativeKernel((void*)fwd_mega, dim3(grid_blocks), dim3(NT), args, DYN_LDS, stream);
  if (e != hipSuccess) fprintf(stderr, "cooperative launch failed: %s (grid %d)\n", hipGetErrorString(e), grid_blocks);
}
```

```cpp
#include <hip/hip_runtime.h>
#include <hip/hip_cooperative_groups.h>
#include <cstdio>
namespace cg = cooperative_groups;

typedef _Float16 h16;
typedef __attribute__((ext_vector_type(8))) _Float16 h16x8;
typedef __attribute__((ext_vector_type(4))) _Float16 h16x4;
typedef __attribute__((ext_vector_type(16))) float f32x16;
typedef __attribute__((ext_vector_type(4))) unsigned u32x4;

#define DI __device__ __forceinline__

constexpr int NB = 8, SEQ = 4096, CTXL = 256, NTOK = 4352, MTOT = 34816, DM = 1024, FFH = 2816;
constexpr int PXW = 2048;
constexpr int QKVW = 2048;
constexpr int NCH = 136;
constexpr int NCHT = NB * NCH;
constexpr int PX_QD = 0, PX_KVD = 384, PX_U = 640, PX_SQ = 1152, PX_SK = 1664, PX_SV = 1792, PX_KR = 1920;
constexpr int PX_MLAO = 0, PX_S5O = 640, PX_SWAO = 1152;

constexpr size_t WO_IN = 0;
constexpr size_t WO_UQ = WO_IN + (size_t)5120 * 1024;
constexpr size_t WO_UKV = WO_UQ + (size_t)768 * 384;
constexpr size_t WO_GLU = WO_UKV + (size_t)1024 * 256;
constexpr size_t WO_BR = WO_GLU + (size_t)512 * 512;
constexpr size_t WO_OUT = WO_BR + (size_t)3 * 1024 * 512;
constexpr size_t WO_F1 = WO_OUT + (size_t)1024 * 1024;
constexpr size_t WO_F2 = WO_F1 + (size_t)5632 * 1024;
constexpr size_t W16_HALVES = WO_F2 + (size_t)1024 * 2816;

constexpr size_t OFF_W16 = 0;
constexpr size_t OFF_MQ = OFF_W16 + W16_HALVES * 2;
constexpr size_t OFF_P = OFF_MQ + (size_t)32 * 512 * 768 * 2;
constexpr size_t OFF_HX = OFF_P + (size_t)32 * 256 * 512 * 2;
constexpr size_t OFF_PX = OFF_HX + (size_t)MTOT * 1024 * 2;
constexpr size_t OFF_QKV = OFF_PX + (size_t)MTOT * PXW * 2;
constexpr size_t OFF_YACT = OFF_QKV + (size_t)MTOT * QKVW * 2;
constexpr size_t OFF_S = OFF_YACT + (size_t)MTOT * 512 * 2;
constexpr size_t OFF_HIN = OFF_S + (size_t)NCHT * 32 * 256 * 2;
constexpr size_t OFF_CTXH = OFF_HIN + (size_t)NCHT * 32 * 256 * 2;
constexpr size_t OFF_MOD = OFF_CTXH + (size_t)2048 * 1024 * 4;
constexpr size_t OFF_POW = OFF_MOD + (size_t)2 * 9 * 6144 * 4;
constexpr size_t OFF_BB = OFF_POW + (size_t)2 * 32 * 2 * 64 * 33 * 8;
constexpr size_t OFF_LAG = OFF_BB + (size_t)2 * 32 * 2 * 64 * 16 * 8;
constexpr size_t OFF_BAR = OFF_LAG + (size_t)32 * 2 * 32 * 256 * 4;
constexpr size_t WS_NEED = OFF_BAR + 16384;

constexpr int SMEM_BYTES = 131072;
constexpr int DYN_LDS = SMEM_BYTES + 16;
constexpr int NT = 512;
constexpr size_t OFF_GATES = OFF_QKV;
static_assert(OFF_GATES + (size_t)MTOT * 3072 * 2 == OFF_CTXH, "gates region");

struct Params {
  const float* in[30];
  float* out;
  char* ws;
};

enum { I_X = 0, I_C, I_CTX, I_CCTX, I_WADA, I_BADA, I_N1G, I_N2G, I_WIN, I_QAG, I_KVAG, I_WUQ, I_WUKV, I_MQKG,
       I_LRE, I_LIM, I_LSTEP, I_BRE, I_BIM, I_CRE, I_CIM, I_S5D, I_WGLU, I_BGLU, I_SQKG, I_SINK, I_WBR, I_WOUT, I_F1, I_F2 };

typedef const Params __attribute__((address_space(4))) CParams;
__device__ __forceinline__ CParams* launder(CParams* p) { asm volatile("" : "+s"(p)); return p; }

__device__ __forceinline__ int otid() { int t = threadIdx.x; asm volatile("" : "+v"(t)); return t; }
DI float shx(float v, int mask, int lane) { return __builtin_bit_cast(float, __builtin_amdgcn_ds_bpermute((lane ^ mask) << 2, __builtin_bit_cast(int, v))); }
DI float wave_sum_(float v, int lane) {
#pragma unroll
  for (int o = 32; o > 0; o >>= 1) v += shx(v, o, lane);
  return v;
}
#define wave_sum(v) wave_sum_((v), lane)
DI float sigmoidf_(float x) { return __builtin_amdgcn_rcpf(1.f + __builtin_amdgcn_exp2f(-1.4426950408889634f * x)); }
DI float gelu_tanh(float x) { return x * sigmoidf_(1.5957691216057308f * (x + 0.044715f * x * x * x)); }
DI int crow(int i, int h) { return (i & 3) + 8 * (i >> 2) + 4 * h; }

struct RowInfo { int mr; size_t ridx; bool isctx; };
DI RowInfo rowinfo(int row) {
  RowInfo r;
  int b = row / NTOK, pos = row - b * NTOK;
  r.isctx = pos < CTXL;
  r.mr = r.isctx ? 8 : b;
  r.ridx = r.isctx ? (size_t)(b * CTXL + pos) : (size_t)(b * SEQ + pos - CTXL);
  return r;
}

#ifndef REPG
#define REPG 1
#endif
#ifndef REPA
#define REPA 1
#endif
#ifndef PMODE
#define PMODE 7
#endif
template <int NI, int RR, class AF>
DI void gemm_core_(f32x16 (&acc)[2][NI], AF af, const h16* __restrict__ Bt, int ldb, int K, char* smem) {
  const int tid5 = otid();
  const int tid = tid5 & 255, lane = tid & 63, wid = tid >> 6;
  h16* As = (h16*)(smem + (tid5 >> 8) * 36864);
  h16* Bs = As + 128 * 72;
  const int wr = wid >> 1, wc = wid & 1, lr = lane & 31, lh = lane >> 5;
#pragma unroll 1
  for (int rep = 0; rep < RR; ++rep) {
#pragma unroll
  for (int mi = 0; mi < 2; ++mi)
#pragma unroll
    for (int ni = 0; ni < NI; ++ni)
#pragma unroll
      for (int i = 0; i < 16; ++i) acc[mi][ni][i] = 0.f;
  u32x4 ra[4], rb[NI * 2];
#pragma unroll
  for (int i = 0; i < 4; ++i) { int c = tid + 256 * i; ra[i] = *(const u32x4*)af(c >> 3, (c & 7) * 8); }
#pragma unroll
  for (int i = 0; i < NI * 2; ++i) { int c = tid + 256 * i; rb[i] = *(const u32x4*)(Bt + (size_t)(c >> 3) * ldb + (c & 7) * 8); }
  for (int k0 = 0; k0 < K; k0 += 64) {
    __syncthreads();
#pragma unroll
    for (int i = 0; i < 4; ++i) { int c = tid + 256 * i; *(u32x4*)(As + (c >> 3) * 72 + (c & 7) * 8) = ra[i]; }
#pragma unroll
    for (int i = 0; i < NI * 2; ++i) { int c = tid + 256 * i; *(u32x4*)(Bs + (c >> 3) * 72 + (c & 7) * 8) = rb[i]; }
    __syncthreads();
    if (k0 + 64 < K) {
#pragma unroll
      for (int i = 0; i < 4; ++i) { int c = tid + 256 * i; ra[i] = *(const u32x4*)af(c >> 3, k0 + 64 + (c & 7) * 8); }
#pragma unroll
      for (int i = 0; i < NI * 2; ++i) { int c = tid + 256 * i; rb[i] = *(const u32x4*)(Bt + (size_t)(c >> 3) * ldb + k0 + 64 + (c & 7) * 8); }
    }
#pragma unroll
    for (int ks = 0; ks < 4; ++ks) {
      h16x8 a[2], b[NI];
#pragma unroll
      for (int mi = 0; mi < 2; ++mi) a[mi] = *(const h16x8*)(As + (wr * 64 + mi * 32 + lr) * 72 + ks * 16 + lh * 8);
#pragma unroll
      for (int ni = 0; ni < NI; ++ni) b[ni] = *(const h16x8*)(Bs + (wc * NI * 32 + ni * 32 + lr) * 72 + ks * 16 + lh * 8);
#pragma unroll
      for (int mi = 0; mi < 2; ++mi)
#pragma unroll
        for (int ni = 0; ni < NI; ++ni) acc[mi][ni] = __builtin_amdgcn_mfma_f32_32x32x16_f16(a[mi], b[ni], acc[mi][ni], 0, 0, 0);
    }
  }
  }
}
template <int NI, class AF>
DI void gemm_core(f32x16 (&acc)[2][NI], AF af, const h16* __restrict__ Bt, int ldb, int K, char* smem) { gemm_core_<NI, REPG>(acc, af, Bt, ldb, K, smem); }
template <int NI, class AF>
DI void gemm_core1(f32x16 (&acc)[2][NI], AF af, const h16* __restrict__ Bt, int ldb, int K, char* smem) { gemm_core_<NI, 1>(acc, af, Bt, ldb, K, smem); }
template <int NI, class EF>
DI void gemm_epi(f32x16 (&acc)[2][NI], EF ef) {
  const int tid_ = otid(); const int lane = tid_ & 63, wid = (tid_ >> 6) & 3;
  const int wr = wid >> 1, wc = wid & 1, lr = lane & 31, lh = lane >> 5;
#pragma unroll
  for (int mi = 0; mi < 2; ++mi)
#pragma unroll
    for (int ni = 0; ni < NI; ++ni)
#pragma unroll
      for (int i = 0; i < 16; ++i) ef(wr * 64 + mi * 32 + crow(i, lh), wc * NI * 32 + ni * 32 + lr, acc[mi][ni][i]);
}

DI void ph_ada(CParams* PP_, char* smem) {
  CParams& P = *launder(PP_);
  float* sc = (float*)smem;
  float* red = sc + 9 * 1024;
  float* mod = (float*)(P.ws + OFF_MOD);
  const float* cin = P.in[I_C]; const float* cctx = P.in[I_CCTX]; const float* wada = P.in[I_WADA]; const float* bada = P.in[I_BADA];
  const int tid = otid();
  for (int item = (int)gridDim.x - 1 - (int)blockIdx.x; item < 384; item += gridDim.x) {
    const int l = item / 192, n0 = (item % 192) * 32;
    for (int i = tid; i < 9 * 1024; i += NT) {
      int r = i >> 10, k = i & 1023;
      float v = (r < 8) ? cin[r * 1024 + k] : cctx[k];
      sc[i] = v / (1.f + expf(-v));
    }
    __syncthreads();
    const int cx = tid & 31, kg = tid >> 5;
    float acc[9];
#pragma unroll
    for (int r = 0; r < 9; ++r) acc[r] = 0.f;
    const float* w = wada + (size_t)l * 1024 * 6144 + n0 + cx;
#pragma unroll 1
    for (int k0 = kg * 64; k0 < kg * 64 + 64; k0 += 16) {
      float wv[16];
#pragma unroll
      for (int e = 0; e < 16; ++e) wv[e] = w[(size_t)(k0 + e) * 6144];
#pragma unroll
      for (int e = 0; e < 16; ++e)
#pragma unroll
        for (int r = 0; r < 9; ++r) acc[r] += sc[r * 1024 + k0 + e] * wv[e];
    }
#pragma unroll
    for (int r = 0; r < 9; ++r) red[(kg * 9 + r) * 32 + cx] = acc[r];
    __syncthreads();
    for (int i = tid; i < 9 * 32; i += NT) {
      int r = i >> 5, cc = i & 31;
      float v = 0.f;
#pragma unroll
      for (int q = 0; q < 16; ++q) v += red[(q * 9 + r) * 32 + cc];
      mod[(size_t)(l * 9 + r) * 6144 + n0 + cc] = v + bada[l * 6144 + n0 + cc];
    }
    __syncthreads();
  }
}

DI int map_win(int n) {
  if (n < 640) return n;
  if (n < 1152) return 672 + (n - 640);
  if (n < 1664) return 1184 + (n - 1152);
  if (n < 1920) return 1696 + (n - 1664);
  if (n < 1952) return 640 + (n - 1920);
  if (n < 2048) return -1;
  return 1952 + (n - 2048);
}
DI int map_f1(int n) {
  const int t = n >> 8, w = n & 255;
  return (w < 128) ? (t * 128 + w) : (FFH + t * 128 + (w - 128));
}
DI void ph_convert(CParams* PP_, int l, char* smem) {
  CParams& P = *launder(PP_);
  float* tile = (float*)smem;
  h16* W = (h16*)(P.ws + OFF_W16);
  const int tid = otid(), tx = tid & 63, ty = tid >> 6;
  constexpr int C0 = 1280, C1 = C0 + 72, C2 = C1 + 64, C3 = C2 + 64, C4 = C3 + 384, C5 = C4 + 256, C6 = C5 + 1408, C7 = C6 + 704;
  struct TileDesc { const float* src; h16* dst; int K, ldsrc, k0, n0, scol; };
  auto desc = [&](int t) {
    TileDesc d; int nt, id, tt;
    if (t < C0) { id = 0; tt = t; d.src = P.in[I_WIN] + (size_t)l * 1024 * 5024; d.ldsrc = 5024; d.K = 1024; nt = 80; d.dst = W + WO_IN; }
    else if (t < C1) { id = 1; tt = t - C0; d.src = P.in[I_WUQ] + (size_t)l * 384 * 768; d.ldsrc = 768; d.K = 384; nt = 12; d.dst = W + WO_UQ; }
    else if (t < C2) { id = 1; tt = t - C1; d.src = P.in[I_WUKV] + (size_t)l * 256 * 1024; d.ldsrc = 1024; d.K = 256; nt = 16; d.dst = W + WO_UKV; }
    else if (t < C3) { id = 1; tt = t - C2; d.src = P.in[I_WGLU] + (size_t)l * 512 * 512; d.ldsrc = 512; d.K = 512; nt = 8; d.dst = W + WO_GLU; }
    else if (t < C4) { id = 1; tt = t - C3; int r = tt / 128; tt -= r * 128; d.src = P.in[I_WBR] + ((size_t)l * 3 + r) * 512 * 1024; d.ldsrc = 1024; d.K = 512; nt = 16; d.dst = W + WO_BR + (size_t)r * 1024 * 512; }
    else if (t < C5) { id = 1; tt = t - C4; d.src = P.in[I_WOUT] + (size_t)l * 1024 * 1024; d.ldsrc = 1024; d.K = 1024; nt = 16; d.dst = W + WO_OUT; }
    else if (t < C6) { id = 2; tt = t - C5; d.src = P.in[I_F1] + (size_t)l * 1024 * 5632; d.ldsrc = 5632; d.K = 1024; nt = 88; d.dst = W + WO_F1; }
    else { id = 1; tt = t - C6; d.src = P.in[I_F2] + (size_t)l * 2816 * 1024; d.ldsrc = 1024; d.K = 2816; nt = 16; d.dst = W + WO_F2; }
    d.k0 = (tt / nt) * 64; d.n0 = (tt % nt) * 64;
    int scol = d.n0 + tx;
    if (id == 0) scol = map_win(scol);
    else if (id == 2) scol = map_f1(scol);
    d.scol = scol;
    return d;
  };
  float rv[8];
  auto loadt = [&](const TileDesc& d) {
#pragma unroll
    for (int i = 0; i < 8; ++i) rv[i] = (d.scol >= 0) ? d.src[(size_t)(d.k0 + ty + 8 * i) * d.ldsrc + d.scol] : 0.f;
  };
  int t = blockIdx.x;
  if (t < C7) { TileDesc d0 = desc(t); loadt(d0); }
  for (; t < C7; t += gridDim.x) {
    const TileDesc d = desc(t);
#pragma unroll
    for (int i = 0; i < 8; ++i) tile[(ty + 8 * i) * 65 + tx] = rv[i];
    __syncthreads();
    if (t + (int)gridDim.x < C7) { const TileDesc dn = desc(t + gridDim.x); loadt(dn); }
#pragma unroll
    for (int i = 0; i < 8; ++i) { const int nn = ty + 8 * i; d.dst[(size_t)(d.n0 + nn) * d.K + d.k0 + tx] = (h16)tile[tx * 65 + nn]; }
    __syncthreads();
  }
}

DI void ph_s5pow(CParams* PP_) {
  CParams& P = *launder(PP_);
  const int t = blockIdx.x * NT + otid();
  if (t >= 8192) return;
  const int p = t & 63, dir = (t >> 6) & 1, g = (t >> 7) & 31, l = t >> 12;
  const size_t gi = ((size_t)(l * 2 + dir) * 32 + g);
  double lr = (double)P.in[I_LRE][gi * 64 + p]; if (lr > -1e-4) lr = -1e-4;
  const double li = (double)P.in[I_LIM][gi * 64 + p];
  const double dt = exp((double)P.in[I_LSTEP][gi]);
  const double mag = exp(lr * dt);
  double sn, cs; sincos(li * dt, &sn, &cs);
  const double ar = mag * cs, ai = mag * sn;
  float2* pw = (float2*)(P.ws + OFF_POW) + (size_t)l * (32 * 2 * 64 * 33) + ((size_t)(g * 2 + dir) * 64 + p) * 33;
  double pr = 1.0, pi = 0.0;
  for (int k = 0; k < 33; ++k) {
    pw[k] = make_float2((float)pr, (float)pi);
    double nr = pr * ar - pi * ai, ni = pr * ai + pi * ar; pr = nr; pi = ni;
  }
  const double den = lr * lr + li * li;
  const double cr = ((ar - 1.0) * lr + ai * li) / den, ci = (ai * lr - (ar - 1.0) * li) / den;
  float2* bb = (float2*)(P.ws + OFF_BB) + (size_t)l * (32 * 2 * 64 * 16) + ((size_t)(g * 2 + dir) * 64 + p) * 16;
  for (int j = 0; j < 16; ++j) {
    double br = (double)P.in[I_BRE][(gi * 64 + p) * 16 + j], bi = (double)P.in[I_BIM][(gi * 64 + p) * 16 + j];
    bb[j] = make_float2((float)(cr * br - ci * bi), (float)(cr * bi + ci * br));
  }
}
DI void ph_s5lag(CParams* PP_, int l, char* smem) {
  CParams& P = *launder(PP_);
  const float2* pw = (const float2*)(P.ws + OFF_POW) + (size_t)l * (32 * 2 * 64 * 33);
  const float2* bb = (const float2*)(P.ws + OFF_BB) + (size_t)l * (32 * 2 * 64 * 16);
  float* lag = (float*)(P.ws + OFF_LAG);
  const float* cre_g = P.in[I_CRE]; const float* cim_g = P.in[I_CIM];
  float2* pwS = (float2*)smem;
  float2* bbS = pwS + 64 * 8;
  float2* cS = bbS + 64 * 16;
  const int tid = otid();
  unsigned* qctr = (unsigned*)(P.ws + OFF_BAR) + 3650 + l;
  volatile __attribute__((address_space(3))) unsigned* qslot = (volatile __attribute__((address_space(3))) unsigned*)(smem + SMEM_BYTES + 8);
  for (;;) {
    __syncthreads();
    if (tid == 0) *qslot = __hip_atomic_fetch_add(qctr, 1u, __ATOMIC_RELAXED, __HIP_MEMORY_SCOPE_AGENT);
    __syncthreads();
    const int item = (int)*qslot;
    if (item >= 256) break;
    const int kq = item & 3, dir = (item >> 2) & 1, g = item >> 3;
    const size_t gi = ((size_t)(l * 2 + dir) * 32 + g);
    const size_t gb = (size_t)(g * 2 + dir) * 64;
    for (int i = tid; i < 512; i += NT) { int p = i >> 3, k = i & 7; pwS[i] = pw[(gb + p) * 33 + kq * 8 + k]; }
    for (int i = tid; i < 1024; i += NT) bbS[i] = bb[gb * 16 + i];
    for (int i = tid; i < 1024; i += NT) cS[i] = make_float2(cre_g[gi * 1024 + i], cim_g[gi * 1024 + i]);
    __syncthreads();
    const int kh = tid >> 8, i = (tid >> 4) & 15, j = tid & 15;
    float sm[4];
#pragma unroll
    for (int k = 0; k < 4; ++k) sm[k] = 0.f;
#pragma unroll 4
    for (int p = 0; p < 64; ++p) {
      const float2 c = cS[i * 64 + p]; const float2 b = bbS[p * 16 + j];
      const float cbr = c.x * b.x - c.y * b.y, cbi = c.x * b.y + c.y * b.x;
#pragma unroll
      for (int k = 0; k < 4; ++k) { const float2 a = pwS[p * 8 + kh * 4 + k]; sm[k] += cbr * a.x - cbi * a.y; }
    }
#pragma unroll
    for (int k = 0; k < 4; ++k) lag[(((size_t)(g * 2 + dir) * 32 + kq * 8 + kh * 4 + k) * 16 + i) * 16 + j] = sm[k];
    __syncthreads();
  }
}

DI void ph_s5mats(CParams* PP_, int l) {
  CParams& P = *launder(PP_);
  const float2* pw = (const float2*)(P.ws + OFF_POW) + (size_t)l * (32 * 2 * 64 * 33);
  const float2* bb = (const float2*)(P.ws + OFF_BB) + (size_t)l * (32 * 2 * 64 * 16);
  const float* lag = (const float*)(P.ws + OFF_LAG);
  h16* MQ = (h16*)(P.ws + OFF_MQ);
  h16* PM = (h16*)(P.ws + OFF_P);
  const float* cre_g = P.in[I_CRE]; const float* cim_g = P.in[I_CIM]; const float* s5d = P.in[I_S5D];
  const int NMQ = 32 * 512 * 96, NPM = 32 * 256 * 64;
  for (int t = blockIdx.x * NT + otid(); t < NMQ + NPM; t += gridDim.x * NT) {
    h16x8 o;
    if (t < NMQ) {
      const int g = t / (512 * 96); int rem = t - g * (512 * 96);
      const int n = rem / 96, k8 = (rem - n * 96) * 8;
      const int tt = n >> 4, i = n & 15;
      if (k8 < 512) {
        const int s = k8 >> 4, j0 = k8 & 15;
        const float* lf = lag + ((size_t)(g * 2 + 0) * 32) * 256 + i * 16 + j0;
        const float* lb = lag + ((size_t)(g * 2 + 1) * 32) * 256 + i * 16 + j0;
        float v[8];
        if (s < tt) { const float4 a = *(const float4*)(lf + (tt - s) * 256), b = *(const float4*)(lf + (tt - s) * 256 + 4); v[0]=a.x;v[1]=a.y;v[2]=a.z;v[3]=a.w;v[4]=b.x;v[5]=b.y;v[6]=b.z;v[7]=b.w; }
        else if (s > tt) { const float4 a = *(const float4*)(lb + (s - tt) * 256), b = *(const float4*)(lb + (s - tt) * 256 + 4); v[0]=a.x;v[1]=a.y;v[2]=a.z;v[3]=a.w;v[4]=b.x;v[5]=b.y;v[6]=b.z;v[7]=b.w; }
        else {
          const float4 a = *(const float4*)(lf), b = *(const float4*)(lf + 4), c = *(const float4*)(lb), d = *(const float4*)(lb + 4);
          v[0]=a.x+c.x;v[1]=a.y+c.y;v[2]=a.z+c.z;v[3]=a.w+c.w;v[4]=b.x+d.x;v[5]=b.y+d.y;v[6]=b.z+d.z;v[7]=b.w+d.w;
          const float dd = s5d[l * 512 + g * 16 + i];
#pragma unroll
          for (int e = 0; e < 8; ++e) if (j0 + e == i) v[e] += dd;
        }
#pragma unroll
        for (int e = 0; e < 8; ++e) o[e] = (h16)v[e];
      } else {
        const int kk = k8 - 512, dir = kk >> 7, p0 = (kk >> 1) & 63;
        const int ex = dir ? (32 - tt) : (tt + 1);
        const size_t gi = ((size_t)(l * 2 + dir) * 32 + g);
#pragma unroll
        for (int q = 0; q < 4; ++q) {
          const float cr = cre_g[(gi * 16 + i) * 64 + p0 + q], ci = cim_g[(gi * 16 + i) * 64 + p0 + q];
          const float2 a = pw[((size_t)(g * 2 + dir) * 64 + p0 + q) * 33 + ex];
          o[2 * q] = (h16)(cr * a.x - ci * a.y);
          o[2 * q + 1] = (h16)(-(cr * a.y + ci * a.x));
        }
      }
      *(h16x8*)(MQ + (size_t)t * 8) = o;
    } else {
      const int u = t - NMQ;
      const int g = u / (256 * 64); int rem = u - g * (256 * 64);
      const int n = rem >> 6, k8 = (rem & 63) * 8;
      const int dir = n >> 7, p = (n >> 1) & 63, c = n & 1;
      const int s = k8 >> 4, j0 = k8 & 15;
      const int ex = dir ? s : (31 - s);
      const float2 a = pw[((size_t)(g * 2 + dir) * 64 + p) * 33 + ex];
      const float2* bp = bb + ((size_t)(g * 2 + dir) * 64 + p) * 16 + j0;
#pragma unroll
      for (int e = 0; e < 8; ++e) { const float2 b = bp[e]; o[e] = (h16)(c ? (a.x * b.y + a.y * b.x) : (a.x * b.x - a.y * b.y)); }
      *(h16x8*)(PM + (size_t)u * 8) = o;
    }
  }
}

DI void ph_s5scan(CParams* PP_, int l) {
  CParams& P = *launder(PP_);
  const int t = blockIdx.x * NT + otid();
  if (t < 32768) {
  const int p = t & 63, dir = (t >> 6) & 1, g = (t >> 7) & 31, b = t >> 12;
  const float2 a32 = ((const float2*)(P.ws + OFF_POW))[(size_t)l * (32 * 2 * 64 * 33) + ((size_t)(g * 2 + dir) * 64 + p) * 33 + 32];
  const h16* S = (const h16*)(P.ws + OFF_S);
  h16* H = (h16*)(P.ws + OFF_HIN);
  float hr = 0.f, hi = 0.f;
  typedef __attribute__((ext_vector_type(2))) _Float16 h16x2_t;
  auto cidx = [&](int it) {
    const int c = (dir == 0) ? it : ((it < 8) ? (7 - it) : (NCH - 1 - (it - 8)));
    return ((size_t)(b * NCH + c) * 32 + g) * 256 + dir * 128 + p * 2;
  };
  unsigned raw[8], nraw[8];
#pragma unroll
  for (int e = 0; e < 8; ++e) raw[e] = *(const unsigned*)(S + cidx(e));
#pragma unroll 1
  for (int it0 = 0; it0 < NCH; it0 += 8) {
    if (it0 + 8 < NCH) {
#pragma unroll
      for (int e = 0; e < 8; ++e) nraw[e] = *(const unsigned*)(S + cidx(it0 + 8 + e));
    }
#pragma unroll
    for (int e = 0; e < 8; ++e) {
      const h16x2_t sv = __builtin_bit_cast(h16x2_t, raw[e]);
      h16x2_t hv; hv[0] = (h16)hr; hv[1] = (h16)hi;
      *(unsigned*)(H + cidx(it0 + e)) = __builtin_bit_cast(unsigned, hv);
      const float nr = a32.x * hr - a32.y * hi + (float)sv[0], ni = a32.x * hi + a32.y * hr + (float)sv[1];
      hr = nr; hi = ni;
    }
#pragma unroll
    for (int e = 0; e < 8; ++e) raw[e] = nraw[e];
  }
  }
}

DI void ph_norm(CParams* PP_, int l, int which) {
  CParams& P = *launder(PP_);
  const int tid_ = otid(); const int lane = tid_ & 63, wid = tid_ >> 6;
  h16* hx = (h16*)(P.ws + OFF_HX);
  const float* mod = (const float*)(P.ws + OFF_MOD);
  const float* gsrc = P.in[which ? I_N2G : I_N1G] + l * 1024;
  const bool from_in = (l == 0 && which == 0);
  const float* src_c = from_in ? P.in[I_CTX] : (const float*)(P.ws + OFF_CTXH);
  const float* src_x = from_in ? P.in[I_X] : (const float*)P.out;
  float4 g4[4];
#pragma unroll
  for (int i = 0; i < 4; ++i) g4[i] = *(const float4*)(gsrc + i * 256 + lane * 4);
  const int stride = gridDim.x * 8;
  int row = blockIdx.x * 8 + wid;
  float4 v[4], nv[4];
  if (row < MTOT) {
    const RowInfo ri = rowinfo(row);
    const float* src = (ri.isctx ? src_c : src_x) + ri.ridx * 1024;
#pragma unroll
    for (int i = 0; i < 4; ++i) v[i] = *(const float4*)(src + i * 256 + lane * 4);
  }
  for (; row < MTOT; row += stride) {
    const RowInfo ri = rowinfo(row);
    const float* sh = mod + (size_t)(l * 9 + ri.mr) * 6144 + (which ? 3 : 0) * 1024;
    const float* scl = sh + 1024;
    if (row + stride < MTOT) {
      const RowInfo rn = rowinfo(row + stride);
      const float* srcn = (rn.isctx ? src_c : src_x) + rn.ridx * 1024;
#pragma unroll
      for (int i = 0; i < 4; ++i) nv[i] = *(const float4*)(srcn + i * 256 + lane * 4);
    }
    float4 s1[4], s0[4];
#pragma unroll
    for (int i = 0; i < 4; ++i) { s1[i] = *(const float4*)(scl + i * 256 + lane * 4); s0[i] = *(const float4*)(sh + i * 256 + lane * 4); }
    float ss = 0.f;
#pragma unroll
    for (int i = 0; i < 4; ++i) ss += v[i].x * v[i].x + v[i].y * v[i].y + v[i].z * v[i].z + v[i].w * v[i].w;
    ss = wave_sum(ss);
    const float rstd = rsqrtf(ss * (1.f / 1024.f) + 1e-6f);
#pragma unroll
    for (int i = 0; i < 4; ++i) {
      const int c = i * 256 + lane * 4;
      h16x4 o;
      o[0] = (h16)(v[i].x * rstd * g4[i].x * (1.f + s1[i].x) + s0[i].x);
      o[1] = (h16)(v[i].y * rstd * g4[i].y * (1.f + s1[i].y) + s0[i].y);
      o[2] = (h16)(v[i].z * rstd * g4[i].z * (1.f + s1[i].z) + s0[i].z);
      o[3] = (h16)(v[i].w * rstd * g4[i].w * (1.f + s1[i].w) + s0[i].w);
      *(h16x4*)(hx + (size_t)row * 1024 + c) = o;
    }
#pragma unroll
    for (int i = 0; i < 4; ++i) v[i] = nv[i];
  }
}
DI void ph_prep(CParams* PP_, int l) {
  CParams& P = *launder(PP_);
  const int tid_ = otid(); const int lane = tid_ & 63, wid = tid_ >> 6;
  h16* px = (h16*)(P.ws + OFF_PX);
  const float* qag = P.in[I_QAG] + l * 384;
  const float* kvag = P.in[I_KVAG] + l * 256;
  const float* sqg = P.in[I_SQKG] + l * 128;
  const int aidx = lane & 31;
  const float freq = exp2f(-(float)(aidx & 15) * (13.287712379549449f / 16.f));
  float gq6[6], gkv4[4];
#pragma unroll
  for (int i = 0; i < 6; ++i) gq6[i] = qag[i * 64 + lane];
#pragma unroll
  for (int i = 0; i < 4; ++i) gkv4[i] = kvag[i * 64 + lane];
  const float gsq = sqg[lane], gsk = sqg[64 + lane];
  const int stride = gridDim.x * 8;
  h16 rq[6], rkv[4], rh[10];
  auto loadrow = [&](int r) {
    const h16* p = px + (size_t)r * PXW;
#pragma unroll
    for (int i = 0; i < 6; ++i) rq[i] = p[PX_QD + i * 64 + lane];
#pragma unroll
    for (int i = 0; i < 4; ++i) rkv[i] = p[PX_KVD + i * 64 + lane];
#pragma unroll
    for (int hh = 0; hh < 10; ++hh) rh[hh] = p[PX_SQ + hh * 64 + lane];
  };
  if (blockIdx.x * 8 + wid < MTOT) loadrow(blockIdx.x * 8 + wid);
  for (int row = blockIdx.x * 8 + wid; row < MTOT; row += stride) {
    h16* pr = px + (size_t)row * PXW;
    const int b = row / NTOK, pos = row - b * NTOK;
    const bool lat = pos >= CTXL;
    const int tpos = pos - CTXL;
    float vq[6], vkv[4], vh[10];
#pragma unroll
    for (int i = 0; i < 6; ++i) vq[i] = (float)rq[i];
#pragma unroll
    for (int i = 0; i < 4; ++i) vkv[i] = (float)rkv[i];
#pragma unroll
    for (int hh = 0; hh < 10; ++hh) vh[hh] = (float)rh[hh];
    if (row + stride < MTOT) loadrow(row + stride);
    float cs = 1.f, sn = 0.f;
    if (lat) { const float ang = (float)((aidx < 16) ? (tpos >> 6) : (tpos & 63)) * freq; sincosf(ang, &sn, &cs); }
    float ssq = 0.f, sskv = 0.f;
#pragma unroll
    for (int i = 0; i < 6; ++i) ssq += vq[i] * vq[i];
#pragma unroll
    for (int i = 0; i < 4; ++i) sskv += vkv[i] * vkv[i];
    float ssh[10];
#pragma unroll
    for (int hh = 0; hh < 10; ++hh) ssh[hh] = vh[hh] * vh[hh];
#pragma unroll
    for (int o = 32; o > 0; o >>= 1) {
      const float t0 = shx(ssq, o, lane), t1 = shx(sskv, o, lane);
      float tt[10];
#pragma unroll
      for (int hh = 0; hh < 10; ++hh) tt[hh] = shx(ssh[hh], o, lane);
      ssq += t0; sskv += t1;
#pragma unroll
      for (int hh = 0; hh < 10; ++hh) ssh[hh] += tt[hh];
    }
    const float rq = rsqrtf(ssq * (1.f / 384.f) + 1e-6f), rkv = rsqrtf(sskv * (1.f / 256.f) + 1e-6f);
#pragma unroll
    for (int i = 0; i < 6; ++i) pr[PX_QD + i * 64 + lane] = (h16)(vq[i] * rq * gq6[i]);
#pragma unroll
    for (int i = 0; i < 4; ++i) pr[PX_KVD + i * 64 + lane] = (h16)(vkv[i] * rkv * gkv4[i]);
#pragma unroll
    for (int hh = 0; hh < 10; ++hh) {
      const float rstd = rsqrtf(ssh[hh] * (1.f / 64.f) + 1e-6f);
      const float vn = vh[hh] * rstd * ((hh < 8) ? gsq : gsk);
      const float partner = shx(vn, 32, lane);
      const float o = (lane < 32) ? (vn * cs - partner * sn) : (vn * cs + partner * sn);
      pr[PX_SQ + hh * 64 + lane] = (h16)o;
    }
  }
}

DI void ph_final(CParams* PP_, int l) {
  CParams& P = *launder(PP_);
  const int tid_ = otid(); const int lane = tid_ & 63, wid = tid_ >> 6;
  h16* qkv = (h16*)(P.ws + OFF_QKV);
  const h16* px = (const h16*)(P.ws + OFF_PX);
  const float* gq = P.in[I_MQKG] + l * 192;
  const float* gk = gq + 96;
  const int aidx = lane & 15;
  const float freq = exp2f(-(float)(aidx & 7) * (13.287712379549449f / 8.f));
  const float gq0 = gq[lane], gk0 = gk[lane];
  const float gq1 = (lane < 32) ? gq[64 + lane] : 0.f, gk1 = (lane < 32) ? gk[64 + lane] : 0.f;
  const int stride = gridDim.x * 8;
  h16 r0[16], r1[8], rk;
  auto loadrow = [&](int r) {
    const h16* q = qkv + (size_t)r * QKVW;
    rk = (lane < 32) ? px[(size_t)r * PXW + PX_KR + lane] : (h16)0.f;
#pragma unroll
    for (int hh = 0; hh < 16; ++hh) r0[hh] = q[hh * 96 + lane];
#pragma unroll
    for (int hh = 0; hh < 8; ++hh) r1[hh] = (lane < 32) ? q[hh * 96 + 64 + lane] : (h16)0.f;
  };
  if (blockIdx.x * 8 + wid < MTOT) loadrow(blockIdx.x * 8 + wid);
  for (int row = blockIdx.x * 8 + wid; row < MTOT; row += stride) {
    h16* qr = qkv + (size_t)row * QKVW;
    const int b = row / NTOK, pos = row - b * NTOK;
    const bool lat = pos >= CTXL;
    const int tpos = pos - CTXL;
    float v0[16], v1[8];
    const float kpe = (float)rk;
#pragma unroll
    for (int hh = 0; hh < 16; ++hh) v0[hh] = (float)r0[hh];
#pragma unroll
    for (int hh = 0; hh < 8; ++hh) v1[hh] = (float)r1[hh];
    if (row + stride < MTOT) loadrow(row + stride);
    float cs = 1.f, sn = 0.f;
    if (lat) { const float ang = (float)((aidx < 8) ? (tpos >> 6) : (tpos & 63)) * freq; sincosf(ang, &sn, &cs); }
    float ss[16];
#pragma unroll
    for (int hh = 0; hh < 16; ++hh) { const float w1 = (hh < 8) ? v1[hh] : kpe; ss[hh] = v0[hh] * v0[hh] + w1 * w1; }
#pragma unroll
    for (int o = 32; o > 0; o >>= 1) {
      float tt[16];
#pragma unroll
      for (int hh = 0; hh < 16; ++hh) tt[hh] = shx(ss[hh], o, lane);
#pragma unroll
      for (int hh = 0; hh < 16; ++hh) ss[hh] += tt[hh];
    }
#pragma unroll
    for (int hh = 0; hh < 16; ++hh) {
      const bool isk = hh >= 8;
      const float rstd = rsqrtf(ss[hh] * (1.f / 96.f) + 1e-6f);
      const float o0 = v0[hh] * rstd * (isk ? gk0 : gq0);
      const float w1 = isk ? kpe : v1[hh & 7];
      const float v1n = w1 * rstd * (isk ? gk1 : gq1);
      const float partner = shx(v1n, 16, lane);
      const float o1 = ((lane & 16) == 0) ? (v1n * cs - partner * sn) : (v1n * cs + partner * sn);
      qr[hh * 96 + lane] = (h16)o0;
      if (lane < 32) qr[hh * 96 + 64 + lane] = (h16)o1;
    }
  }
}

template <int DQK>
DI void attn_block(const h16* __restrict__ Q, int ldq, const h16* __restrict__ Kb, int ldk,
                           const h16* __restrict__ Vb, int ldv, h16* __restrict__ O, int ldo,
                           int ntiles, int na, int t0b, int qpos0, const float* sinkv, bool has_sink, float scale_l2, char* smem, bool gqa = false) {
  constexpr int KS = DQK + 8;
  constexpr int NKCH = 64 * (DQK / 8);
  constexpr int NKC = (NKCH + NT - 1) / NT;
  constexpr int CPK = DQK / 8;
  constexpr int VS = 96;
  constexpr int HB = 64 * KS + 64 * VS;
  typedef short v4s_t __attribute__((__vector_size__(4 * sizeof(short))));
  h16* const buf0 = (h16*)smem;
  const int tid = otid(), lane = tid & 63, wid = tid >> 6, lr = lane & 31, lh = lane >> 5;
  const int qrow_w = gqa ? ((wid & 1) * 32) : (wid * 32);
  const int qcol_w = gqa ? ((wid >> 1) * 64) : 0;
  const float sink_l2 = has_sink ? sinkv[gqa ? (wid >> 1) : 0] * 1.4426950408889634f : 0.f;
  h16x8 qf[DQK / 16];
  {
    const h16* qp = Q + (size_t)(qrow_w + lr) * ldq + qcol_w + lh * 8;
#pragma unroll
    for (int ks = 0; ks < DQK / 16; ++ks) qf[ks] = *(const h16x8*)(qp + ks * 16);
  }
  f32x16 o[2];
  float m, lsum;
  u32x4 kreg[NKC], vreg[1];
#pragma unroll 1
  for (int rep = 0; rep < REPA; ++rep) {
#pragma unroll
  for (int d = 0; d < 2; ++d)
#pragma unroll
    for (int i = 0; i < 16; ++i) o[d][i] = 0.f;
  m = has_sink ? sink_l2 : -1e30f;
  lsum = (has_sink && lh == 0) ? 1.f : 0.f;
  const bool full = (rep == REPA - 1);
  const bool do_qk = full || (PMODE & 1), do_sm = full || (PMODE & 2), do_pv = full || (PMODE & 4);
  auto load_tile = [&](int it) {
    const int kp0 = ((it < na) ? it : (t0b + (it - na))) * 64;
#pragma unroll
    for (int i = 0; i < NKC; ++i) { int c = tid + NT * i; if (c < NKCH) { int key = c / CPK, dc = c - key * CPK; kreg[i] = *(const u32x4*)(Kb + (size_t)(kp0 + key) * ldk + dc * 8); } }
    { int key = tid >> 3, dvc = tid & 7; vreg[0] = *(const u32x4*)(Vb + (size_t)(kp0 + key) * ldv + dvc * 8); }
  };
  auto store_tile = [&](h16* Ksd) {
    h16* Vtd = Ksd + 64 * KS;
#pragma unroll
    for (int i = 0; i < NKC; ++i) { int c = tid + NT * i; if (c < NKCH) { int key = c / CPK, dc = c - key * CPK; *(u32x4*)(Ksd + key * KS + dc * 8) = kreg[i]; } }
    { int key = tid >> 3, dvc = tid & 7; *(u32x4*)(Vtd + key * VS + dvc * 8) = vreg[0]; }
  };
  auto qk = [&](f32x16 (&sd)[2], const h16* Ksrc) {
    h16x8 kf[2][DQK / 16];
#pragma unroll
    for (int ks = 0; ks < DQK / 16; ++ks)
#pragma unroll
      for (int kt = 0; kt < 2; ++kt) kf[kt][ks] = *(const h16x8*)(Ksrc + (kt * 32 + lr) * KS + ks * 16 + lh * 8);
    const f32x16 zv = {0.f, 0.f, 0.f, 0.f, 0.f, 0.f, 0.f, 0.f, 0.f, 0.f, 0.f, 0.f, 0.f, 0.f, 0.f, 0.f};
#pragma unroll
    for (int kt = 0; kt < 2; ++kt) sd[kt] = __builtin_amdgcn_mfma_f32_32x32x16_f16(kf[kt][0], qf[0], zv, 0, 0, 0);
#pragma unroll
    for (int ks = 1; ks < DQK / 16; ++ks)
#pragma unroll
      for (int kt = 0; kt < 2; ++kt) sd[kt] = __builtin_amdgcn_mfma_f32_32x32x16_f16(kf[kt][ks], qf[ks], sd[kt], 0, 0, 0);
  };
  load_tile(0);
  store_tile(buf0);
  if (ntiles > 1) { load_tile(1); store_tile(buf0 + HB); }
  __syncthreads();
  if (ntiles > 2) load_tile(2);
  f32x16 s[2], sn[2];
#pragma unroll
  for (int kt = 0; kt < 2; ++kt)
#pragma unroll
    for (int i = 0; i < 16; ++i) { s[kt][i] = 0.f; sn[kt][i] = 0.f; }
  const int wid_u = __builtin_amdgcn_readfirstlane(wid);
  auto tclass = [&](int it) -> int {
    if (it < na) return 1;
    const int klo = (t0b + (it - na)) * 64 - CTXL, khi = klo + 63;
    const int qlo = qpos0 + (gqa ? ((wid_u & 1) * 32) : (wid_u * 32)), qhi = qlo + 31;
    if (khi < qlo - 128 || klo > qhi + 128) return 0;
    if (klo >= qhi - 128 && khi <= qlo + 128) return 1;
    return 2;
  };
  int bcur = 0;
#pragma unroll 1
  for (int it = 0; it < ntiles; ++it) {
    const int bnext = (bcur == 2) ? 0 : bcur + 1;
    const int bfree = (bnext == 2) ? 0 : bnext + 1;
    const h16* Vt = buf0 + bcur * HB + 64 * KS;
    const int cls = tclass(it);
    if (cls != 0) {
    qk(s, buf0 + bcur * HB);
    h16x8 vfr[2][2][2];
    if (do_pv) {
#pragma unroll
      for (int kt = 0; kt < 2; ++kt)
#pragma unroll
        for (int st = 0; st < 2; ++st)
#pragma unroll
          for (int d = 0; d < 2; ++d) {
            const h16* vp = Vt + (kt * 32 + st * 16 + 4 * lh + ((lane >> 2) & 3)) * VS + d * 32 + 16 * ((lane >> 4) & 1) + 4 * (lane & 3);
            const v4s_t lo = __builtin_amdgcn_ds_read_tr16_b64_v4i16((__attribute__((address_space(3))) v4s_t*)vp);
            const v4s_t hi = __builtin_amdgcn_ds_read_tr16_b64_v4i16((__attribute__((address_space(3))) v4s_t*)(vp + 8 * VS));
            vfr[kt][st][d] = __builtin_bit_cast(h16x8, __builtin_shufflevector(lo, hi, 0, 1, 2, 3, 4, 5, 6, 7));
          }
    }
    if (do_sm) {
    if (cls == 2) {
      const int kl0 = (t0b + (it - na)) * 64 - CTXL;
      const int qp = qpos0 + qrow_w + lr;
      const int dq = qp - kl0 - 4 * lh;
#pragma unroll
      for (int kt = 0; kt < 2; ++kt)
#pragma unroll
        for (int i = 0; i < 16; ++i) { const int d = dq - (kt * 32 + (i & 3) + 8 * (i >> 2)); if (d > 128 || d < -128) s[kt][i] = -3.0e38f; }
    }
    float mx = -3.0e38f;
#pragma unroll
    for (int kt = 0; kt < 2; ++kt)
#pragma unroll
      for (int i = 0; i < 16; ++i) mx = fmaxf(mx, s[kt][i]);
    if (__builtin_amdgcn_ballot_w64(mx * scale_l2 > m + 8.f) != 0ull) {
      mx = fmaxf(mx, shx(mx, 32, lane));
      const float mn = fmaxf(m, mx * scale_l2);
      const float alpha = __builtin_amdgcn_exp2f(m - mn);
      m = mn;
      lsum *= alpha;
#pragma unroll
      for (int d = 0; d < 2; ++d)
#pragma unroll
        for (int i = 0; i < 16; ++i) o[d][i] *= alpha;
    }
    typedef float f32x2_t __attribute__((ext_vector_type(2)));
    f32x2_t ps2 = {0.f, 0.f};
    const f32x2_t sc2 = {scale_l2, scale_l2}, nm2 = {-m, -m};
#pragma unroll
    for (int kt = 0; kt < 2; ++kt)
#pragma unroll
      for (int i = 0; i < 16; i += 2) {
        f32x2_t t = {s[kt][i], s[kt][i + 1]};
        t = t * sc2 + nm2;
        f32x2_t pv; pv.x = __builtin_amdgcn_exp2f(t.x); pv.y = __builtin_amdgcn_exp2f(t.y);
        s[kt][i] = pv.x; s[kt][i + 1] = pv.y; ps2 += pv;
      }
    lsum += ps2.x + ps2.y;
    }
    if (do_pv) {
#pragma unroll
    for (int kt = 0; kt < 2; ++kt)
#pragma unroll
      for (int st = 0; st < 2; ++st) {
        h16x8 pf;
#pragma unroll
        for (int j = 0; j < 8; ++j) pf[j] = (h16)s[kt][8 * st + j];
#pragma unroll
        for (int d = 0; d < 2; ++d) {
          const h16x8 va = vfr[kt][st][d];
          o[d] = __builtin_amdgcn_mfma_f32_32x32x16_f16(va, pf, o[d], 0, 0, 0);
        }
      }
    }
    }
    if (it + 2 < ntiles) store_tile(buf0 + bfree * HB);
    __syncthreads();
    if (it + 3 < ntiles) load_tile(it + 3);
    bcur = bnext;
  }
  if (!full) {
#pragma unroll
    for (int d = 0; d < 2; ++d)
#pragma unroll
      for (int i = 0; i < 16; ++i) { asm volatile("" :: "v"(o[d][i])); asm volatile("" :: "v"(s[d][i])); }
    asm volatile("" :: "v"(lsum), "v"(m));
  }
  }
  const float lt = lsum + shx(lsum, 32, lane);
  const float inv = 1.f / lt;
  h16* op = O + (size_t)(qrow_w + lr) * ldo + qcol_w;
#pragma unroll
  for (int d = 0; d < 2; ++d)
#pragma unroll
    for (int g4 = 0; g4 < 4; ++g4) {
      h16x4 w;
#pragma unroll
      for (int j = 0; j < 4; ++j) w[j] = (h16)(o[d][g4 * 4 + j] * inv);
      *(h16x4*)(op + d * 32 + g4 * 8 + lh * 4) = w;
    }
  __syncthreads();
}

#define XB_TMO      128
#define XB_XCNT(j)  (256  + 64 * (j))
#define XB_XSUB(j)  (1280 + 64 * (j))
#define XB_XGEN(j)  (2304 + 64 * (j))
#define XB_TOP      3328
#define XB_TOPGEN   3392
#define XCD_BAR_WORDS 3456
#define XB_SPIN_CAP (1u << 20)
#define LAS __attribute__((address_space(3)))
DI unsigned xb_ld(unsigned* p)              { return __hip_atomic_load(p, __ATOMIC_RELAXED, __HIP_MEMORY_SCOPE_AGENT); }
DI unsigned xb_add(unsigned* p, unsigned v) { return __hip_atomic_fetch_add(p, v, __ATOMIC_RELAXED, __HIP_MEMORY_SCOPE_AGENT); }
DI unsigned xb_xcc_id() { return (unsigned)__builtin_amdgcn_s_getreg((3 << 11) | 20) & 0xFu; }
#define XB_SPIN(cond, bar) do { unsigned _sp = 0; while (cond) { __builtin_amdgcn_s_sleep(1); \
    if ((++_sp & 255u) == 0u) { if (xb_ld(&(bar)[XB_TMO])) break; if (_sp > XB_SPIN_CAP) { atomicAdd(&(bar)[XB_TMO], 1u); break; } } } } while (0)
struct XcdBarrier { unsigned* bar; unsigned x; volatile LAS unsigned* st; };
DI XcdBarrier xcd_barrier_post(unsigned* bar, volatile LAS unsigned* st) {
  XcdBarrier b; b.bar = bar; b.x = xb_xcc_id(); b.st = st;
  if (threadIdx.x == 0) (void)xb_add(&bar[XB_XCNT(b.x)], 1u);
  return b;
}
DI void xcd_barrier_complete(unsigned* bar, unsigned x, unsigned& nloc, unsigned& nx) {
  const unsigned G = gridDim.x * gridDim.y * gridDim.z;
  unsigned sum, cnt, mine, sp = 0u;
  for (;;) {
    sum = 0u; cnt = 0u; mine = 0u;
#pragma unroll
    for (unsigned j = 0; j < 16; ++j) { const unsigned c = xb_ld(&bar[XB_XCNT(j)]); sum += c; cnt += (c > 0u) ? 1u : 0u; mine = (j == x) ? c : mine; }
    if (sum == G) break;
    __builtin_amdgcn_s_sleep(1);
    if ((++sp & 255u) == 0u) { if (xb_ld(&bar[XB_TMO])) break; if (sp > XB_SPIN_CAP) { atomicAdd(&bar[XB_TMO], 1u); break; } }
  }
  nloc = mine > 0u ? mine : 1u; nx = cnt > 0u ? cnt : 1u;
}
DI void xcd_barrier(CParams* PP_, volatile LAS unsigned* st) {
  XcdBarrier b; b.bar = (unsigned*)(launder(PP_)->ws + OFF_BAR); b.x = xb_xcc_id(); b.st = st;
  asm volatile("s_waitcnt vmcnt(0)" ::: "memory");
  __syncthreads();
  if (threadIdx.x == 0) {
    unsigned* bar = b.bar;
    __builtin_amdgcn_s_waitcnt(0);
    unsigned nloc = b.st[0], nx = b.st[1];
    if (nloc == 0u) { xcd_barrier_complete(bar, b.x, nloc, nx); b.st[0] = nloc; b.st[1] = nx; }
    const unsigned old = xb_add(&bar[XB_XSUB(b.x)], 1u);
    const unsigned gen = old / nloc;
    if (old + 1u == (gen + 1u) * nloc) {
      __builtin_amdgcn_fence(__ATOMIC_RELEASE, "agent");
      asm volatile("s_waitcnt vmcnt(0)" ::: "memory");
      const unsigned og = xb_add(&bar[XB_TOP], 1u);
      const unsigned tg = og / nx;
      if (og + 1u == (tg + 1u) * nx) xb_add(&bar[XB_TOPGEN], 1u);
      else XB_SPIN(xb_ld(&bar[XB_TOPGEN]) == tg, bar);
      __builtin_amdgcn_fence(__ATOMIC_ACQUIRE, "agent");
      xb_add(&bar[XB_XGEN(b.x)], 1u);
      asm volatile("s_waitcnt vmcnt(0)" ::: "memory");
    } else {
      XB_SPIN(xb_ld(&bar[XB_XGEN(b.x)]) == gen, bar);
      __builtin_amdgcn_fence(__ATOMIC_ACQUIRE, "agent");
      asm volatile("s_waitcnt vmcnt(0)" ::: "memory");
    }
  }
  __syncthreads();
}

namespace pg8 {
constexpr int BM = 256, BK = 64, HALF = 128, HTB = HALF * BK * 2, NXCD = 8, WGM = 8;
DI int lds_byte(int r, int c) { const int st = (r >> 4) * 2 + (c >> 5), rr = r & 15, cc = c & 31, ob = rr * 64 + cc * 2; return st * 1024 + (ob ^ (((ob >> 9) & 1) << 5)); }
DI void stage_rc(int b, int& R, int& C) { const int st = b / 1024, sb = b % 1024, swz = sb ^ (((sb >> 9) & 1) << 5); R = (st >> 1) * 16 + swz / 64; C = (st & 1) * 32 + (swz % 64) / 2; }
DI int perm32(int rho) { const int n = rho >> 4, i = rho & 15; return 8 * (i >> 2) + 4 * n + (i & 3); }
struct Unit { int pm, pn, seg; };
DI bool next_unit(int i, int G, int c, int nM, int nN, bool lat, int nseg, Unit& u) {
  if (lat) nM = 128;
  const int nwg = nM * nN;
  const int ib = i / nseg; u.seg = i - ib * nseg;
  const long L = (long)ib * G + c; if (L >= nwg) return false;
  int wgid = (int)L; { const int q = nwg / NXCD, r = nwg % NXCD, xcd = wgid % NXCD, off = wgid / NXCD; wgid = (xcd < r ? xcd * (q + 1) : r * (q + 1) + (xcd - r) * q) + off; }
  const int nig = WGM * nN, gid = wgid / nig, fm = gid * WGM, gsz = (nM - fm) < WGM ? (nM - fm) : WGM;
  u.pm = fm + ((wgid % nig) % gsz); u.pn = (wgid % nig) / gsz;
  if (lat) u.pm = u.pm + (u.pm >> 4) + 1;
  return true;
}
typedef float f32x4 __attribute__((ext_vector_type(4)));

template <bool PERM, class Epi>
DI void gemm_fast(LAS unsigned char* lds, const h16* A, int lda, const h16* Bt, int K, int nM, int nN, const Epi& E, bool lat = false,
                   int nseg = 1, int segA0 = 0, int segA1 = 0, int segA2 = 0, size_t segB = 0) {
  const int tid = otid(), wid = __builtin_amdgcn_readfirstlane(tid >> 6), lane = tid & 63, wr = wid >> 2, wc = wid & 3, fr = lane & 15, fq = lane >> 4;
  const int nt = K / BK;
  const int G = gridDim.x, cblk = blockIdx.x;
  unsigned voffA[2], voffB[2];
#pragma unroll
  for (int i = 0; i < 2; ++i) { int R, C; stage_rc(tid * 16 + i * 8192, R, C); const int Rb = PERM ? ((R & ~31) + perm32(R & 31)) : R;
    voffA[i] = (unsigned)(R * lda + C) * 2u; voffB[i] = (unsigned)(Rb * K + C) * 2u; }
  const size_t kstep = (size_t)(BK * 2);
  const size_t hstepA = (size_t)HALF * lda * 2, hstepB = (size_t)HALF * K * 2;
  const size_t tstepA = 2 * hstepA, tstepB = 2 * hstepB;
  const unsigned ldsw = (unsigned)wid * 1024u;
  const int aoff = lds_byte(wr * 64 + fr, fq * 8), boff = lds_byte(wc * 32 + fr, fq * 8);
#define PG8_SA(b, h) (((b) * 2 + (h)) * HTB)
#define PG8_SB(b, h) ((4 + (b) * 2 + (h)) * HTB)
#define PG8_STAGE(bufoff, gbase, voff) do { _Pragma("unroll") for (int _i = 0; _i < 2; ++_i) \
    __builtin_amdgcn_global_load_lds((const unsigned*)((const char*)(gbase) + (voff)[_i]), (LAS unsigned*)(lds + (bufoff) + ldsw + _i * 8192), 16, 0, 0); } while (0)
#define PG8_LDA(dst, b, h) do { _Pragma("unroll") for (int m = 0; m < 4; ++m) _Pragma("unroll") for (int k = 0; k < 2; ++k) dst[m][k] = *(const LAS h16x8*)(lds + PG8_SA(b, h) + aoff + m * 2048 + k * 1024); } while (0)
#define PG8_LDB(dst, b, h) do { _Pragma("unroll") for (int n = 0; n < 2; ++n) _Pragma("unroll") for (int k = 0; k < 2; ++k) dst[n][k] = *(const LAS h16x8*)(lds + PG8_SB(b, h) + boff + n * 2048 + k * 1024); } while (0)
#define PG8_MMA(ai, bj, At, Bt_) do { __builtin_amdgcn_s_setprio(1); _Pragma("unroll") for (int m = 0; m < 4; ++m) _Pragma("unroll") for (int n = 0; n < 2; ++n) _Pragma("unroll") for (int k = 0; k < 2; ++k) \
    acc[ai][bj][m][n] = __builtin_amdgcn_mfma_f32_16x16x32_f16(Bt_[n][k], At[m][k], acc[ai][bj][m][n], 0, 0, 0); __builtin_amdgcn_s_setprio(0); } while (0)
#define PG8_WAIT_V(n) asm volatile("s_waitcnt vmcnt(" #n ")" ::: "memory")
#define PG8_WAIT_L(n) asm volatile("s_waitcnt lgkmcnt(" #n ")" ::: "memory")
#define PG8_BAR __builtin_amdgcn_s_barrier()
#define PG8_SCHED __builtin_amdgcn_sched_barrier(0)
  Unit cur, nxt; int ui = 0;
  if (!next_unit(0, G, cblk, nM, nN, lat, nseg, cur)) return;
  auto sa = [&](int sg) { return (size_t)(sg == 0 ? segA0 : (sg == 1 ? segA1 : segA2)); };
  f32x4 acc[2][2][4][2];
#pragma unroll
  for (int a = 0; a < 2; ++a)
#pragma unroll
    for (int b = 0; b < 2; ++b)
#pragma unroll
      for (int m = 0; m < 4; ++m)
#pragma unroll
        for (int n = 0; n < 2; ++n) acc[a][b][m][n] = (f32x4){0.f, 0.f, 0.f, 0.f};
  h16x8 At[4][2], B0[2][2], B1[2][2];
  const char* cA = (const char*)A + sa(cur.seg) + (size_t)cur.pm * tstepA; const char* cB = (const char*)Bt + cur.seg * segB + (size_t)cur.pn * tstepB;
  PG8_STAGE(PG8_SB(0, 0), cB, voffB); PG8_STAGE(PG8_SA(0, 0), cA, voffA); PG8_STAGE(PG8_SB(0, 1), cB + hstepB, voffB); PG8_STAGE(PG8_SA(0, 1), cA + hstepA, voffA);
  if (wr == 1) PG8_BAR;
  PG8_WAIT_V(4); PG8_BAR;
  PG8_STAGE(PG8_SB(1, 0), cB + kstep, voffB); PG8_STAGE(PG8_SA(1, 0), cA + kstep, voffA); PG8_STAGE(PG8_SB(1, 1), cB + hstepB + kstep, voffB);
  PG8_WAIT_V(6); PG8_BAR;
  for (;;) {
    const bool has_next = next_unit(ui + 1, G, cblk, nM, nN, lat, nseg, nxt);
    const char* nA = has_next ? (const char*)A + sa(nxt.seg) + (size_t)nxt.pm * tstepA : cA; const char* nB = has_next ? (const char*)Bt + nxt.seg * segB + (size_t)nxt.pn * tstepB : cB;
    for (int t = 0; t < nt; t += 2) {
      const bool last = (t == nt - 2);
      const char* a1 = cA + (size_t)(t + 1) * kstep;
      const char* a2 = last ? nA : cA + (size_t)(t + 2) * kstep; const char* b2 = last ? nB : cB + (size_t)(t + 2) * kstep;
      const char* a3 = a2 + kstep; const char* b3 = b2 + kstep;
      PG8_LDB(B0, 0, 0); PG8_SCHED; PG8_LDA(At, 0, 0); PG8_STAGE(PG8_SA(1, 1), a1 + hstepA, voffA);
      PG8_WAIT_L(8); PG8_BAR; PG8_WAIT_L(0); PG8_MMA(0, 0, At, B0); PG8_BAR; PG8_SCHED;
      PG8_LDB(B1, 0, 1); PG8_STAGE(PG8_SB(0, 0), b2, voffB);
      PG8_BAR; PG8_WAIT_L(0); PG8_MMA(0, 1, At, B1); PG8_BAR;
      PG8_LDA(At, 0, 1); PG8_STAGE(PG8_SA(0, 0), a2, voffA);
      PG8_BAR; PG8_WAIT_L(0); PG8_MMA(1, 0, At, B0); PG8_BAR; PG8_SCHED;
      PG8_STAGE(PG8_SB(0, 1), b2 + hstepB, voffB);
      PG8_WAIT_V(6); PG8_BAR; PG8_MMA(1, 1, At, B1); PG8_BAR;
      PG8_LDB(B0, 1, 0); PG8_SCHED; PG8_LDA(At, 1, 0); PG8_STAGE(PG8_SA(0, 1), a2 + hstepA, voffA);
      PG8_WAIT_L(8); PG8_BAR; PG8_WAIT_L(0); PG8_MMA(0, 0, At, B0); PG8_BAR; PG8_SCHED;
      PG8_LDB(B1, 1, 1); PG8_STAGE(PG8_SB(1, 0), b3, voffB);
      PG8_BAR; PG8_WAIT_L(0); PG8_MMA(0, 1, At, B1); PG8_BAR;
      PG8_LDA(At, 1, 1); PG8_STAGE(PG8_SA(1, 0), a3, voffA);
      PG8_BAR; PG8_WAIT_L(0); PG8_MMA(1, 0, At, B0); PG8_BAR; PG8_SCHED;
      PG8_STAGE(PG8_SB(1, 1), b3 + hstepB, voffB);
      PG8_WAIT_V(6); PG8_BAR; PG8_MMA(1, 1, At, B1); PG8_BAR;
    }
    { const int et = otid(); const int ew = et >> 6, el = et & 63; E(acc, cur, ew >> 2, ew & 3, el & 15, el >> 4); }
    if (!has_next) break;
#pragma unroll
    for (int a = 0; a < 2; ++a)
#pragma unroll
      for (int b = 0; b < 2; ++b)
#pragma unroll
        for (int m = 0; m < 4; ++m)
#pragma unroll
          for (int n = 0; n < 2; ++n) acc[a][b][m][n] = (f32x4){0.f, 0.f, 0.f, 0.f};
    cur = nxt; cA = nA; cB = nB; ++ui;
  }
  PG8_WAIT_V(0);
  if (wr == 0) PG8_BAR;
  PG8_BAR;
#undef PG8_SA
#undef PG8_SB
#undef PG8_STAGE
#undef PG8_LDA
#undef PG8_LDB
#undef PG8_MMA
#undef PG8_WAIT_V
#undef PG8_WAIT_L
#undef PG8_BAR
#undef PG8_SCHED
}
template <class F>
DI void epi8(const f32x4 (&acc)[2][2][4][2], const Unit& u, int wr, int wc, int fr, int fq, F fn) {
#pragma unroll
  for (int ai = 0; ai < 2; ++ai)
#pragma unroll
    for (int m = 0; m < 4; ++m) {
      const int row = u.pm * BM + ai * HALF + wr * 64 + m * 16 + fr;
#pragma unroll
      for (int bj = 0; bj < 2; ++bj) fn(row, u.pn * BM + bj * HALF + wc * 32 + 8 * fq, acc[ai][bj][m][0], acc[ai][bj][m][1]);
    }
}
DI h16x8 pack8(f32x4 lo, f32x4 hi) { h16x8 o; o[0] = (h16)lo[0]; o[1] = (h16)lo[1]; o[2] = (h16)lo[2]; o[3] = (h16)lo[3]; o[4] = (h16)hi[0]; o[5] = (h16)hi[1]; o[6] = (h16)hi[2]; o[7] = (h16)hi[3]; return o; }
}
using pg8::f32x4;

DI void ph_gemm_in(CParams* PP_, char* smem) {
  CParams& P = *launder(PP_);
  const h16* hx = (const h16*)(P.ws + OFF_HX);
  const h16* W = (const h16*)(P.ws + OFF_W16) + WO_IN;
  h16* px = (h16*)(P.ws + OFF_PX);
  auto E = [=](const f32x4 (&acc)[2][2][4][2], const pg8::Unit& u, int wr, int wc, int fr, int fq) {
    pg8::epi8(acc, u, wr, wc, fr, fq, [=](int row, int col, f32x4 lo, f32x4 hi) { *(h16x8*)(px + (size_t)row * PXW + col) = pg8::pack8(lo, hi); });
  };
  pg8::gemm_fast<true>((LAS unsigned char*)smem, hx, 1024, W, 1024, 136, 8, E);
}
DI void ph_upproj(CParams* PP_, int l, char* smem) {
  CParams& P = *launder(PP_);
  const h16* W = (const h16*)(P.ws + OFF_W16);
  h16* px = (h16*)(P.ws + OFF_PX);
  h16* qkv = (h16*)(P.ws + OFF_QKV);
  h16* S = (h16*)(P.ws + OFF_S);
  const h16* PM = (const h16*)(P.ws + OFF_P);
  {
    auto E = [=](const f32x4 (&acc)[2][2][4][2], const pg8::Unit& u, int wr, int wc, int fr, int fq) {
      pg8::epi8(acc, u, wr, wc, fr, fq, [=](int row, int col, f32x4 lo, f32x4 hi) { *(h16x8*)(qkv + (size_t)row * QKVW + col) = pg8::pack8(lo, hi); });
    };
    pg8::gemm_fast<true>((LAS unsigned char*)smem, px + PX_QD, PXW, W + WO_UQ, 384, 136, 3, E);
  }
  {
    auto E = [=](const f32x4 (&acc)[2][2][4][2], const pg8::Unit& u, int wr, int wc, int fr, int fq) {
      pg8::epi8(acc, u, wr, wc, fr, fq, [=](int row, int n, f32x4 lo, f32x4 hi) {
        const int hh = n >> 7, e = n & 127;
        const int col = (e < 64) ? (768 + hh * 96 + e) : (1536 + hh * 64 + (e - 64));
        *(h16x8*)(qkv + (size_t)row * QKVW + col) = pg8::pack8(lo, hi);
      });
    };
    pg8::gemm_fast<true>((LAS unsigned char*)smem, px + PX_KVD, PXW, W + WO_UKV, 256, 136, 4, E);
  }
  __syncthreads();
  const int tid = otid();
  const int half = tid >> 8;
  unsigned* qctr = (unsigned*)(P.ws + OFF_BAR) + 3610 + l;
  volatile LAS unsigned* qslot = (volatile LAS unsigned*)(smem + SMEM_BYTES + 8);
  for (;;) {
    __syncthreads();
    if (tid == 0) *qslot = __hip_atomic_fetch_add(qctr, 1u, __ATOMIC_RELAXED, __HIP_MEMORY_SCOPE_AGENT);
    __syncthreads();
    const int pr = (int)*qslot;
    if (pr >= 288) break;
    const int tt = pr * 2 + half; const int g = tt / 18; const int r2 = tt % 18; const int m0 = (r2 >> 1) * 128, n0 = (r2 & 1) * 128;
    f32x16 acc[2][2];
    gemm_core<2>(acc, [=](int r, int k) { int cc = m0 + r; if (cc > NCHT - 1) cc = NCHT - 1; return px + (size_t)(cc * 32 + (k >> 4)) * PXW + PX_U + g * 16 + (k & 15); },
                 PM + ((size_t)g * 256 + n0) * 512, 512, 512, smem);
    gemm_epi<2>(acc, [=](int r, int c, float v) { const int cc = m0 + r; if (cc < NCHT) S[((size_t)cc * 32 + g) * 256 + n0 + c] = (h16)v; });
  }
  __syncthreads();
}
DI void ph_mix(CParams* PP_, int l, char* smem) {
  CParams& P = *launder(PP_);
  h16* px = (h16*)(P.ws + OFF_PX);
  const h16* qkv = (const h16*)(P.ws + OFF_QKV);
  const h16* MQ = (const h16*)(P.ws + OFF_MQ);
  const h16* HIN = (const h16*)(P.ws + OFF_HIN);
  h16* yact = (h16*)(P.ws + OFF_YACT);
  const float* sinkp = P.in[I_SINK];
  const float L2E = 1.4426950408889634f;
  constexpr int NA = NB * 8 * 17;
  auto run_mla = [&](int h, int b, int qt) {
    const size_t row0 = (size_t)b * NTOK + qt * 256;
    const size_t brow = (size_t)b * NTOK;
    const int ntiles = (qt < 1) ? 4 : 68;
    attn_block<96>(qkv + row0 * QKVW + h * 96, QKVW, qkv + brow * QKVW + 768 + h * 96, QKVW, qkv + brow * QKVW + 1536 + h * 64, QKVW,
                   px + row0 * PXW + PX_MLAO + h * 64, PXW, ntiles, ntiles, 0, 0, nullptr, false, 0.10206207261596577f * L2E, smem);
  };
  for (int t = blockIdx.x; t < 1024; t += gridDim.x) {
    const int r = t >> 8, blk = t & 255, xcd = blk & 7, slot = blk >> 3;
    const int pair = r * 16 + xcd * 2 + (slot >> 4);
    run_mla(pair & 7, pair >> 3, 1 + (slot & 15));
  }
  unsigned* qctr = (unsigned*)(P.ws + OFF_BAR) + 3600 + l;
  volatile LAS unsigned* qslot = (volatile LAS unsigned*)(smem + SMEM_BYTES + 8);
  const int tid = otid();
  const int half = tid >> 8;
  constexpr int QTOT = NA + 576 + 64;
  for (;;) {
    __syncthreads();
    if (tid == 0) *qslot = __hip_atomic_fetch_add(qctr, 1u, __ATOMIC_RELAXED, __HIP_MEMORY_SCOPE_AGENT);
    __syncthreads();
    const int q0 = (int)*qslot;
    if (q0 >= QTOT) break;
    const int q = (q0 < 576) ? (NA + q0) : ((q0 < 576 + NA) ? (q0 - 576) : q0);
    if (q < NA) {
      const int u = q; const int kvh = u & 1, b = (u >> 1) & 7, pb = 67 - (u >> 4);
      const size_t row0 = (size_t)b * NTOK + pb * 64;
      const size_t brow = (size_t)b * NTOK;
      int ntiles = 4, t0b = 0, qpos0 = 0;
      if (pb >= 4) {
        const int start = (pb - 4) * 64;
        const int lo = (start - 128 < 0) ? 0 : (start - 128);
        const int hi = (start + 192 > SEQ) ? SEQ : (start + 192);
        t0b = (CTXL + lo) >> 6; ntiles = 4 + ((hi - lo) >> 6); qpos0 = start;
      }
      attn_block<64>(px + row0 * PXW + PX_SQ + kvh * 256, PXW, px + brow * PXW + PX_SK + kvh * 64, PXW, px + brow * PXW + PX_SV + kvh * 64, PXW,
                     px + row0 * PXW + PX_SWAO + kvh * 256, PXW, ntiles, 4, t0b, qpos0, sinkp + l * 8 + kvh * 4, true, 0.125f * L2E, smem, true);
    } else if (q < NA + 576) {
      const int pr = q - NA;
      const int tt = pr * 2 + half; const int g = tt / 36; const int r2 = tt % 36; const int m0 = (r2 >> 2) * 128, n0 = (r2 & 3) * 128;
      f32x16 acc[2][2];
      gemm_core1<2>(acc, [=](int r, int k) {
        int cc = m0 + r; if (cc > NCHT - 1) cc = NCHT - 1;
        return (k < 512) ? (px + (size_t)(cc * 32 + (k >> 4)) * PXW + PX_U + g * 16 + (k & 15)) : (HIN + ((size_t)cc * 32 + g) * 256 + (k - 512));
      }, MQ + ((size_t)g * 512 + n0) * 768, 768, 768, smem);
      gemm_epi<2>(acc, [=](int r, int c, float v) {
        const int cc = m0 + r; const int n = n0 + c;
        if (cc < NCHT) yact[(size_t)(cc * 32 + (n >> 4)) * 512 + g * 16 + (n & 15)] = (h16)gelu_tanh(v);
      });
    } else {
      const int u = q - NA - 576;
      run_mla(u & 7, u >> 3, 0);
    }
  }
  __syncthreads();
}
DI void ph_glu(CParams* PP_, int l, char* smem) {
  CParams& P = *launder(PP_);
  const h16* W = (const h16*)(P.ws + OFF_W16) + WO_GLU;
  const h16* yact = (const h16*)(P.ws + OFF_YACT);
  h16* px = (h16*)(P.ws + OFF_PX);
  const float* bg = P.in[I_BGLU] + l * 512;
  auto E = [=](const f32x4 (&acc)[2][2][4][2], const pg8::Unit& u, int wr, int wc, int fr, int fq) {
    const int colb = u.pn * 256 + wc * 32 + 8 * fq;
    f32x4 b0[2], b1[2];
#pragma unroll
    for (int bj = 0; bj < 2; ++bj) { b0[bj] = *(const f32x4*)(bg + colb + bj * 128); b1[bj] = *(const f32x4*)(bg + colb + bj * 128 + 4); }
#pragma unroll
    for (int ai = 0; ai < 2; ++ai) {
      h16x8 y[4][2];
#pragma unroll
      for (int m = 0; m < 4; ++m)
#pragma unroll
        for (int bj = 0; bj < 2; ++bj) y[m][bj] = *(const h16x8*)(yact + (size_t)(u.pm * 256 + ai * 128 + wr * 64 + m * 16 + fr) * 512 + colb + bj * 128);
      asm volatile("" ::: "memory");
#pragma unroll
      for (int m = 0; m < 4; ++m)
#pragma unroll
        for (int bj = 0; bj < 2; ++bj) {
          const f32x4 lo = acc[ai][bj][m][0], hi = acc[ai][bj][m][1];
          h16x8 o;
#pragma unroll
          for (int e = 0; e < 4; ++e) { o[e] = (h16)((float)y[m][bj][e] * sigmoidf_(lo[e] + b0[bj][e])); o[4 + e] = (h16)((float)y[m][bj][4 + e] * sigmoidf_(hi[e] + b1[bj][e])); }
          *(h16x8*)(px + (size_t)(u.pm * 256 + ai * 128 + wr * 64 + m * 16 + fr) * PXW + PX_S5O + colb + bj * 128) = o;
        }
    }
  };
  pg8::gemm_fast<true>((LAS unsigned char*)smem, yact, 512, W, 512, 136, 2, E, l == 1);
}
DI void ph_gates(CParams* PP_, int l, char* smem) {
  CParams& P = *launder(PP_);
  const h16* hx = (const h16*)(P.ws + OFF_HX);
  const h16* W = (const h16*)(P.ws + OFF_W16) + WO_IN + (size_t)2048 * 1024;
  h16* gt = (h16*)(P.ws + OFF_GATES);
  auto E = [=](const f32x4 (&acc)[2][2][4][2], const pg8::Unit& u, int wr, int wc, int fr, int fq) {
    pg8::epi8(acc, u, wr, wc, fr, fq, [=](int row, int col, f32x4 lo, f32x4 hi) {
      h16x8 o;
#pragma unroll
      for (int e = 0; e < 4; ++e) { o[e] = (h16)sigmoidf_(lo[e]); o[4 + e] = (h16)sigmoidf_(hi[e]); }
      *(h16x8*)(gt + (size_t)row * 3072 + col) = o;
    });
  };
  pg8::gemm_fast<true>((LAS unsigned char*)smem, hx, 1024, W, 1024, 136, 12, E, l == 1);
}
DI void ph_merge(CParams* PP_, int l, char* smem) {
  CParams& P = *launder(PP_);
  const h16* W = (const h16*)(P.ws + OFF_W16) + WO_BR;
  const h16* px = (const h16*)(P.ws + OFF_PX);
  const h16* gt = (const h16*)(P.ws + OFF_GATES);
  h16* mg = (h16*)(P.ws + OFF_HX);
  {
    auto E = [=](const f32x4 (&acc)[2][2][4][2], const pg8::Unit& u, int wr, int wc, int fr, int fq) {
      const int r3 = u.seg;
      const int colb = u.pn * 256 + wc * 32 + 8 * fq;
#pragma unroll
      for (int ai = 0; ai < 2; ++ai) {
        h16x8 g[4][2], prev[4][2];
#pragma unroll
        for (int m = 0; m < 4; ++m)
#pragma unroll
          for (int bj = 0; bj < 2; ++bj) {
            const size_t row = (size_t)(u.pm * 256 + ai * 128 + wr * 64 + m * 16 + fr);
            g[m][bj] = *(const h16x8*)(gt + row * 3072 + r3 * 1024 + colb + bj * 128);
            if (r3 > 0) prev[m][bj] = *(const h16x8*)(mg + row * 1024 + colb + bj * 128);
          }
        asm volatile("" ::: "memory");
#pragma unroll
        for (int m = 0; m < 4; ++m)
#pragma unroll
          for (int bj = 0; bj < 2; ++bj) {
            const size_t row = (size_t)(u.pm * 256 + ai * 128 + wr * 64 + m * 16 + fr);
            const f32x4 lo = acc[ai][bj][m][0], hi = acc[ai][bj][m][1];
            h16x8 o;
#pragma unroll
            for (int e = 0; e < 4; ++e) {
              float a = (float)g[m][bj][e] * lo[e], bb2 = (float)g[m][bj][4 + e] * hi[e];
              if (r3 > 0) { a += (float)prev[m][bj][e]; bb2 += (float)prev[m][bj][4 + e]; }
              o[e] = (h16)a; o[4 + e] = (h16)bb2;
            }
            *(h16x8*)(mg + row * 1024 + colb + bj * 128) = o;
          }
      }
    };
    pg8::gemm_fast<true>((LAS unsigned char*)smem, px, PXW, W, 512, 136, 4, E, l == 1, 3, PX_MLAO * 2, PX_S5O * 2, PX_SWAO * 2, (size_t)1024 * 512 * 2);
  }
}
DI void ph_resid(CParams* PP_, int l, size_t a_off, int K, size_t w_off, int gate_idx, bool fi_mode, char* smem) {
  CParams& P = *launder(PP_);
  int ll = l; asm volatile("" : "+s"(ll));
  const bool from_in = fi_mode && (ll == 0);
  const h16* A = (const h16*)(P.ws + a_off);
  const h16* Wt = (const h16*)(P.ws + OFF_W16) + w_off;
  const float* mod = (const float*)(P.ws + OFF_MOD) + (size_t)l * 9 * 6144 + gate_idx * 1024;
  float* ctxh = (float*)(P.ws + OFF_CTXH);
  float* outp = P.out;
  const float* src_c = from_in ? P.in[I_CTX] : (const float*)ctxh;
  const float* src_x = from_in ? P.in[I_X] : (const float*)outp;
  auto E = [=](const f32x4 (&acc)[2][2][4][2], const pg8::Unit& u, int wr, int wc, int fr, int fq) {
    const int b = u.pm / 17, jt = u.pm - b * 17;
    const bool isctx = (jt == 0);
    const size_t rbase = isctx ? (size_t)b * CTXL : ((size_t)b * SEQ + (size_t)(jt - 1) * 256);
    const float* src = (isctx ? src_c : src_x) + rbase * 1024;
    float* dst = (isctx ? ctxh : outp) + rbase * 1024;
    const float* gm = mod + (size_t)(isctx ? 8 : b) * 6144;
    const int colb = u.pn * 256 + wc * 32 + 4 * fq;
    f32x4 g[2][2];
#pragma unroll
    for (int bj = 0; bj < 2; ++bj)
#pragma unroll
      for (int n = 0; n < 2; ++n) g[bj][n] = *(const f32x4*)(gm + colb + bj * 128 + 16 * n);
#pragma unroll
    for (int ai = 0; ai < 2; ++ai) {
      f32x4 s0[4][2][2];
#pragma unroll
      for (int m = 0; m < 4; ++m)
#pragma unroll
        for (int bj = 0; bj < 2; ++bj)
#pragma unroll
          for (int n = 0; n < 2; ++n) s0[m][bj][n] = *(const f32x4*)(src + (size_t)(ai * 128 + wr * 64 + m * 16 + fr) * 1024 + colb + bj * 128 + 16 * n);
      asm volatile("" ::: "memory");
#pragma unroll
      for (int m = 0; m < 4; ++m)
#pragma unroll
        for (int bj = 0; bj < 2; ++bj)
#pragma unroll
          for (int n = 0; n < 2; ++n) *(f32x4*)(dst + (size_t)(ai * 128 + wr * 64 + m * 16 + fr) * 1024 + colb + bj * 128 + 16 * n) = s0[m][bj][n] + g[bj][n] * acc[ai][bj][m][n];
    }
  };
  pg8::gemm_fast<false>((LAS unsigned char*)smem, A, K, Wt, K, 136, 4, E, ll == 1);
}
DI void ph_ffn1(CParams* PP_, int l, char* smem) {
  CParams& P = *launder(PP_);
  const h16* hx = (const h16*)(P.ws + OFF_HX);
  const h16* W = (const h16*)(P.ws + OFF_W16) + WO_F1;
  h16* hid = (h16*)(P.ws + OFF_PX);
  auto E = [=](const f32x4 (&acc)[2][2][4][2], const pg8::Unit& u, int wr, int wc, int fr, int fq) {
#pragma unroll
    for (int ai = 0; ai < 2; ++ai)
#pragma unroll
      for (int m = 0; m < 4; ++m) {
        const int row = u.pm * 256 + ai * 128 + wr * 64 + m * 16 + fr;
        const int j0 = u.pn * 128 + wc * 32 + 8 * fq;
        h16x8 o;
#pragma unroll
        for (int n = 0; n < 2; ++n)
#pragma unroll
          for (int e = 0; e < 4; ++e) { const float a = acc[ai][0][m][n][e], g = acc[ai][1][m][n][e]; o[4 * n + e] = (h16)(a * sigmoidf_(a) * g); }
        *(h16x8*)(hid + (size_t)row * FFH + j0) = o;
      }
  };
  pg8::gemm_fast<true>((LAS unsigned char*)smem, hx, 1024, W, 1024, 136, 22, E, l == 1);
}

__global__ void __launch_bounds__(512, 2) fwd_mega(Params Pk) {
  CParams* P = (CParams*)__builtin_amdgcn_kernarg_segment_ptr();
  cg::grid_group grid = cg::this_grid();
  extern __shared__ __attribute__((aligned(16))) char smem[];
  volatile LAS unsigned* xst = (volatile LAS unsigned*)(smem + SMEM_BYTES);
  if (threadIdx.x == 0) { xst[0] = 0u; xst[1] = 0u; }
  __syncthreads();
  (void)xcd_barrier_post((unsigned*)(launder(P)->ws + OFF_BAR), xst);
  if (P->ws == nullptr) grid.sync();
  ph_ada(P, smem);
  ph_convert(P, 0, smem);
  ph_s5pow(P);
  xcd_barrier(P, xst);
  for (int l = 0; l < 2; ++l) {
    ph_norm(P, l, 0);
    if (l == 1) ph_convert(P, 1, smem);
    xcd_barrier(P, xst);
    ph_gemm_in(P, smem);
    ph_s5lag(P, l, smem);
    xcd_barrier(P, xst);
    ph_prep(P, l);
    ph_s5mats(P, l);
    xcd_barrier(P, xst);
    ph_upproj(P, l, smem);
    xcd_barrier(P, xst);
    ph_final(P, l);
    ph_s5scan(P, l);
    xcd_barrier(P, xst);
    ph_mix(P, l, smem);
    xcd_barrier(P, xst);
    ph_glu(P, l, smem);
    xcd_barrier(P, xst);
    ph_gates(P, l, smem);
    xcd_barrier(P, xst);
    ph_merge(P, l, smem);
    xcd_barrier(P, xst);
    ph_resid(P, l, OFF_HX, 1024, WO_OUT, 2, true, smem);
    xcd_barrier(P, xst);
    ph_norm(P, l, 1);
    xcd_barrier(P, xst);
    ph_ffn1(P, l, smem);
    xcd_barrier(P, xst);
    ph_resid(P, l, OFF_PX, FFH, WO_F2, 5, false, smem);
    if (l == 0) xcd_barrier(P, xst);
  }
}

extern "C" void kernel_launch(void* const* d_in, const int* in_sizes, int n_in,
                              void* d_out, int out_size, void* d_ws, size_t ws_size,
                              hipStream_t stream) {
  static int grid_blocks = 0;
  if (!grid_blocks) {
    int dev = 0, cus = 0, per_cu = 0;
    (void)hipGetDevice(&dev);
    (void)hipDeviceGetAttribute(&cus, hipDeviceAttributeMultiprocessorCount, dev);
    (void)hipFuncSetAttribute((const void*)fwd_mega, hipFuncAttributeMaxDynamicSharedMemorySize, DYN_LDS);
    (void)hipOccupancyMaxActiveBlocksPerMultiprocessor(&per_cu, fwd_mega, NT, DYN_LDS);
    (void)hipGetLastError();
    grid_blocks = cus;
  }
  if (ws_size < WS_NEED || n_in != 30) { fprintf(stderr, "kernel_launch: ws too small (%zu < %zu) or n_in %d\n", ws_size, (size_t)WS_NEED, n_in); return; }
  (void)hipMemsetAsync((char*)d_ws + OFF_BAR, 0, 16384, stream);
  Params p{};
  for (int i = 0; i < 30; ++i) p.in[i] = (const float*)d_in[i];
  p.out = (float*)d_out;
  p.ws = (char*)d_ws;
  void* args[] = {&p};
  hipError_t e = hipLaunchCooperativeKernel((void*)fwd_mega, dim3(grid_blocks), dim3(NT), args, DYN_LDS, stream);
  if (e != hipSuccess) fprintf(stderr, "cooperative launch failed: %s (grid %d)\n", hipGetErrorString(e), grid_blocks);
}
```

```cpp
#include <hip/hip_runtime.h>
#include <hip/hip_cooperative_groups.h>
#include <cstdio>
namespace cg = cooperative_groups;

typedef _Float16 h16;
typedef __attribute__((ext_vector_type(8))) _Float16 h16x8;
typedef __attribute__((ext_vector_type(4))) _Float16 h16x4;
typedef __attribute__((ext_vector_type(16))) float f32x16;
typedef __attribute__((ext_vector_type(4))) unsigned u32x4;

#define DI __device__ __forceinline__

constexpr int NB = 8, SEQ = 4096, CTXL = 256, NTOK = 4352, MTOT = 34816, DM = 1024, FFH = 2816;
constexpr int PXW = 2048;
constexpr int QKVW = 2048;
constexpr int NCH = 136;
constexpr int NCHT = NB * NCH;
constexpr int PX_QD = 0, PX_KVD = 384, PX_U = 640, PX_SQ = 1152, PX_SK = 1664, PX_SV = 1792, PX_KR = 1920;
constexpr int PX_MLAO = 0, PX_S5O = 640, PX_SWAO = 1152;

constexpr size_t WO_IN = 0;
constexpr size_t WO_UQ = WO_IN + (size_t)5120 * 1024;
constexpr size_t WO_UKV = WO_UQ + (size_t)768 * 384;
constexpr size_t WO_GLU = WO_UKV + (size_t)1024 * 256;
constexpr size_t WO_BR = WO_GLU + (size_t)512 * 512;
constexpr size_t WO_OUT = WO_BR + (size_t)3 * 1024 * 512;
constexpr size_t WO_F1 = WO_OUT + (size_t)1024 * 1024;
constexpr size_t WO_F2 = WO_F1 + (size_t)5632 * 1024;
constexpr size_t W16_HALVES = WO_F2 + (size_t)1024 * 2816;

constexpr size_t OFF_W16 = 0;
constexpr size_t OFF_MQ = OFF_W16 + W16_HALVES * 2;
constexpr size_t OFF_P = OFF_MQ + (size_t)32 * 512 * 768 * 2;
constexpr size_t OFF_HX = OFF_P + (size_t)32 * 256 * 512 * 2;
constexpr size_t OFF_PX = OFF_HX + (size_t)MTOT * 1024 * 2;
constexpr size_t OFF_QKV = OFF_PX + (size_t)MTOT * PXW * 2;
constexpr size_t OFF_YACT = OFF_QKV + (size_t)MTOT * QKVW * 2;
constexpr size_t OFF_S = OFF_YACT + (size_t)MTOT * 512 * 2;
constexpr size_t OFF_HIN = OFF_S + (size_t)NCHT * 32 * 256 * 2;
constexpr size_t OFF_CTXH = OFF_HIN + (size_t)NCHT * 32 * 256 * 2;
constexpr size_t OFF_MOD = OFF_CTXH + (size_t)2048 * 1024 * 4;
constexpr size_t OFF_POW = OFF_MOD + (size_t)2 * 9 * 6144 * 4;
constexpr size_t OFF_BB = OFF_POW + (size_t)2 * 32 * 2 * 64 * 33 * 8;
constexpr size_t OFF_LAG = OFF_BB + (size_t)2 * 32 * 2 * 64 * 16 * 8;
constexpr size_t OFF_BAR = OFF_LAG + (size_t)32 * 2 * 32 * 256 * 4;
constexpr size_t WS_NEED = OFF_BAR + 16384;

constexpr int SMEM_BYTES = 131072;
constexpr int DYN_LDS = SMEM_BYTES + 16;
constexpr int NT = 512;
constexpr size_t OFF_GATES = OFF_QKV;
static_assert(OFF_GATES + (size_t)MTOT * 3072 * 2 == OFF_CTXH, "gates region");

struct Params {
  const float* in[30];
  float* out;
  char* ws;
};

enum { I_X = 0, I_C, I_CTX, I_CCTX, I_WADA, I_BADA, I_N1G, I_N2G, I_WIN, I_QAG, I_KVAG, I_WUQ, I_WUKV, I_MQKG,
       I_LRE, I_LIM, I_LSTEP, I_BRE, I_BIM, I_CRE, I_CIM, I_S5D, I_WGLU, I_BGLU, I_SQKG, I_SINK, I_WBR, I_WOUT, I_F1, I_F2 };

typedef const Params __attribute__((address_space(4))) CParams;
__device__ __forceinline__ CParams* launder(CParams* p) { asm volatile("" : "+s"(p)); return p; }

__device__ __forceinline__ int otid() { int t = threadIdx.x; asm volatile("" : "+v"(t)); return t; }
DI float shx(float v, int mask, int lane) { return __builtin_bit_cast(float, __builtin_amdgcn_ds_bpermute((lane ^ mask) << 2, __builtin_bit_cast(int, v))); }
DI float wave_sum_(float v, int lane) {
#pragma unroll
  for (int o = 32; o > 0; o >>= 1) v += shx(v, o, lane);
  return v;
}
#define wave_sum(v) wave_sum_((v), lane)
DI float sigmoidf_(float x) { return __builtin_amdgcn_rcpf(1.f + __builtin_amdgcn_exp2f(-1.4426950408889634f * x)); }
DI float gelu_tanh(float x) { return x * sigmoidf_(1.5957691216057308f * (x + 0.044715f * x * x * x)); }
DI int crow(int i, int h) { return (i & 3) + 8 * (i >> 2) + 4 * h; }

struct RowInfo { int mr; size_t ridx; bool isctx; };
DI RowInfo rowinfo(int row) {
  RowInfo r;
  int b = row / NTOK, pos = row - b * NTOK;
  r.isctx = pos < CTXL;
  r.mr = r.isctx ? 8 : b;
  r.ridx = r.isctx ? (size_t)(b * CTXL + pos) : (size_t)(b * SEQ + pos - CTXL);
  return r;
}

#ifndef REPG
#define REPG 1
#endif
#ifndef REPA
#define REPA 1
#endif
#ifndef PMODE
#define PMODE 7
#endif
template <int NI, int RR, class AF>
DI void gemm_core_(f32x16 (&acc)[2][NI], AF af, const h16* __restrict__ Bt, int ldb, int K, char* smem) {
  const int tid5 = otid();
  const int tid = tid5 & 255, lane = tid & 63, wid = tid >> 6;
  h16* As = (h16*)(smem + (tid5 >> 8) * 36864);
  h16* Bs = As + 128 * 72;
  const int wr = wid >> 1, wc = wid & 1, lr = lane & 31, lh = lane >> 5;
#pragma unroll 1
  for (int rep = 0; rep < RR; ++rep) {
#pragma unroll
  for (int mi = 0; mi < 2; ++mi)
#pragma unroll
    for (int ni = 0; ni < NI; ++ni)
#pragma unroll
      for (int i = 0; i < 16; ++i) acc[mi][ni][i] = 0.f;
  u32x4 ra[4], rb[NI * 2];
#pragma unroll
  for (int i = 0; i < 4; ++i) { int c = tid + 256 * i; ra[i] = *(const u32x4*)af(c >> 3, (c & 7) * 8); }
#pragma unroll
  for (int i = 0; i < NI * 2; ++i) { int c = tid + 256 * i; rb[i] = *(const u32x4*)(Bt + (size_t)(c >> 3) * ldb + (c & 7) * 8); }
  for (int k0 = 0; k0 < K; k0 += 64) {
    __syncthreads();
#pragma unroll
    for (int i = 0; i < 4; ++i) { int c = tid + 256 * i; *(u32x4*)(As + (c >> 3) * 72 + (c & 7) * 8) = ra[i]; }
#pragma unroll
    for (int i = 0; i < NI * 2; ++i) { int c = tid + 256 * i; *(u32x4*)(Bs + (c >> 3) * 72 + (c & 7) * 8) = rb[i]; }
    __syncthreads();
    if (k0 + 64 < K) {
#pragma unroll
      for (int i = 0; i < 4; ++i) { int c = tid + 256 * i; ra[i] = *(const u32x4*)af(c >> 3, k0 + 64 + (c & 7) * 8); }
#pragma unroll
      for (int i = 0; i < NI * 2; ++i) { int c = tid + 256 * i; rb[i] = *(const u32x4*)(Bt + (size_t)(c >> 3) * ldb + k0 + 64 + (c & 7) * 8); }
    }
#pragma unroll
    for (int ks = 0; ks < 4; ++ks) {
      h16x8 a[2], b[NI];
#pragma unroll
      for (int mi = 0; mi < 2; ++mi) a[mi] = *(const h16x8*)(As + (wr * 64 + mi * 32 + lr) * 72 + ks * 16 + lh * 8);
#pragma unroll
      for (int ni = 0; ni < NI; ++ni) b[ni] = *(const h16x8*)(Bs + (wc * NI * 32 + ni * 32 + lr) * 72 + ks * 16 + lh * 8);
#pragma unroll
      for (int mi = 0; mi < 2; ++mi)
#pragma unroll
        for (int ni = 0; ni < NI; ++ni) acc[mi][ni] = __builtin_amdgcn_mfma_f32_32x32x16_f16(a[mi], b[ni], acc[mi][ni], 0, 0, 0);
    }
  }
  }
}
template <int NI, class AF>
DI void gemm_core(f32x16 (&acc)[2][NI], AF af, const h16* __restrict__ Bt, int ldb, int K, char* smem) { gemm_core_<NI, REPG>(acc, af, Bt, ldb, K, smem); }
template <int NI, class AF>
DI void gemm_core1(f32x16 (&acc)[2][NI], AF af, const h16* __restrict__ Bt, int ldb, int K, char* smem) { gemm_core_<NI, 1>(acc, af, Bt, ldb, K, smem); }
template <int NI, class EF>
DI void gemm_epi(f32x16 (&acc)[2][NI], EF ef) {
  const int tid_ = otid(); const int lane = tid_ & 63, wid = (tid_ >> 6) & 3;
  const int wr = wid >> 1, wc = wid & 1, lr = lane & 31, lh = lane >> 5;
#pragma unroll
  for (int mi = 0; mi < 2; ++mi)
#pragma unroll
    for (int ni = 0; ni < NI; ++ni)
#pragma unroll
      for (int i = 0; i < 16; ++i) ef(wr * 64 + mi * 32 + crow(i, lh), wc * NI * 32 + ni * 32 + lr, acc[mi][ni][i]);
}

DI void ph_ada(CParams* PP_, char* smem) {
  CParams& P = *launder(PP_);
  float* sc = (float*)smem;
  float* red = sc + 9 * 1024;
  float* mod = (float*)(P.ws + OFF_MOD);
  const float* cin = P.in[I_C]; const float* cctx = P.in[I_CCTX]; const float* wada = P.in[I_WADA]; const float* bada = P.in[I_BADA];
  const int tid = otid();
  for (int item = (int)gridDim.x - 1 - (int)blockIdx.x; item < 384; item += gridDim.x) {
    const int l = item / 192, n0 = (item % 192) * 32;
    for (int i = tid; i < 9 * 1024; i += NT) {
      int r = i >> 10, k = i & 1023;
      float v = (r < 8) ? cin[r * 1024 + k] : cctx[k];
      sc[i] = v / (1.f + expf(-v));
    }
    __syncthreads();
    const int cx = tid & 31, kg = tid >> 5;
    float acc[9];
#pragma unroll
    for (int r = 0; r < 9; ++r) acc[r] = 0.f;
    const float* w = wada + (size_t)l * 1024 * 6144 + n0 + cx;
#pragma unroll 1
    for (int k0 = kg * 64; k0 < kg * 64 + 64; k0 += 16) {
      float wv[16];
#pragma unroll
      for (int e = 0; e < 16; ++e) wv[e] = w[(size_t)(k0 + e) * 6144];
#pragma unroll
      for (int e = 0; e < 16; ++e)
#pragma unroll
        for (int r = 0; r < 9; ++r) acc[r] += sc[r * 1024 + k0 + e] * wv[e];
    }
#pragma unroll
    for (int r = 0; r < 9; ++r) red[(kg * 9 + r) * 32 + cx] = acc[r];
    __syncthreads();
    for (int i = tid; i < 9 * 32; i += NT) {
      int r = i >> 5, cc = i & 31;
      float v = 0.f;
#pragma unroll
      for (int q = 0; q < 16; ++q) v += red[(q * 9 + r) * 32 + cc];
      mod[(size_t)(l * 9 + r) * 6144 + n0 + cc] = v + bada[l * 6144 + n0 + cc];
    }
    __syncthreads();
  }
}

DI int map_win(int n) {
  if (n < 640) return n;
  if (n < 1152) return 672 + (n - 640);
  if (n < 1664) return 1184 + (n - 1152);
  if (n < 1920) return 1696 + (n - 1664);
  if (n < 1952) return 640 + (n - 1920);
  if (n < 2048) return -1;
  return 1952 + (n - 2048);
}
DI int map_f1(int n) {
  const int t = n >> 8, w = n & 255;
  return (w < 128) ? (t * 128 + w) : (FFH + t * 128 + (w - 128));
}
DI void ph_convert(CParams* PP_, int l, char* smem) {
  CParams& P = *launder(PP_);
  float* tile = (float*)smem;
  h16* W = (h16*)(P.ws + OFF_W16);
  const int tid = otid(), tx = tid & 63, ty = tid >> 6;
  constexpr int C0 = 1280, C1 = C0 + 72, C2 = C1 + 64, C3 = C2 + 64, C4 = C3 + 384, C5 = C4 + 256, C6 = C5 + 1408, C7 = C6 + 704;
  struct TileDesc { const float* src; h16* dst; int K, ldsrc, k0, n0, scol; };
  auto desc = [&](int t) {
    TileDesc d; int nt, id, tt;
    if (t < C0) { id = 0; tt = t; d.src = P.in[I_WIN] + (size_t)l * 1024 * 5024; d.ldsrc = 5024; d.K = 1024; nt = 80; d.dst = W + WO_IN; }
    else if (t < C1) { id = 1; tt = t - C0; d.src = P.in[I_WUQ] + (size_t)l * 384 * 768; d.ldsrc = 768; d.K = 384; nt = 12; d.dst = W + WO_UQ; }
    else if (t < C2) { id = 1; tt = t - C1; d.src = P.in[I_WUKV] + (size_t)l * 256 * 1024; d.ldsrc = 1024; d.K = 256; nt = 16; d.dst = W + WO_UKV; }
    else if (t < C3) { id = 1; tt = t - C2; d.src = P.in[I_WGLU] + (size_t)l * 512 * 512; d.ldsrc = 512; d.K = 512; nt = 8; d.dst = W + WO_GLU; }
    else if (t < C4) { id = 1; tt = t - C3; int r = tt / 128; tt -= r * 128; d.src = P.in[I_WBR] + ((size_t)l * 3 + r) * 512 * 1024; d.ldsrc = 1024; d.K = 512; nt = 16; d.dst = W + WO_BR + (size_t)r * 1024 * 512; }
    else if (t < C5) { id = 1; tt = t - C4; d.src = P.in[I_WOUT] + (size_t)l * 1024 * 1024; d.ldsrc = 1024; d.K = 1024; nt = 16; d.dst = W + WO_OUT; }
    else if (t < C6) { id = 2; tt = t - C5; d.src = P.in[I_F1] + (size_t)l * 1024 * 5632; d.ldsrc = 5632; d.K = 1024; nt = 88; d.dst = W + WO_F1; }
    else { id = 1; tt = t - C6; d.src = P.in[I_F2] + (size_t)l * 2816 * 1024; d.ldsrc = 1024; d.K = 2816; nt = 16; d.dst = W + WO_F2; }
    d.k0 = (tt / nt) * 64; d.n0 = (tt % nt) * 64;
    int scol = d.n0 + tx;
    if (id == 0) scol = map_win(scol);
    else if (id == 2) scol = map_f1(scol);
    d.scol = scol;
    return d;
  };
  float rv[8];
  auto loadt = [&](const TileDesc& d) {
#pragma unroll
    for (int i = 0; i < 8; ++i) rv[i] = (d.scol >= 0) ? d.src[(size_t)(d.k0 + ty + 8 * i) * d.ldsrc + d.scol] : 0.f;
  };
  int t = blockIdx.x;
  if (t < C7) { TileDesc d0 = desc(t); loadt(d0); }
  for (; t < C7; t += gridDim.x) {
    const TileDesc d = desc(t);
#pragma unroll
    for (int i = 0; i < 8; ++i) tile[(ty + 8 * i) * 65 + tx] = rv[i];
    __syncthreads();
    if (t + (int)gridDim.x < C7) { const TileDesc dn = desc(t + gridDim.x); loadt(dn); }
#pragma unroll
    for (int i = 0; i < 8; ++i) { const int nn = ty + 8 * i; d.dst[(size_t)(d.n0 + nn) * d.K + d.k0 + tx] = (h16)tile[tx * 65 + nn]; }
    __syncthreads();
  }
}

DI void ph_s5pow(CParams* PP_) {
  CParams& P = *launder(PP_);
  const int t = blockIdx.x * NT + otid();
  if (t >= 8192) return;
  const int p = t & 63, dir = (t >> 6) & 1, g = (t >> 7) & 31, l = t >> 12;
  const size_t gi = ((size_t)(l * 2 + dir) * 32 + g);
  double lr = (double)P.in[I_LRE][gi * 64 + p]; if (lr > -1e-4) lr = -1e-4;
  const double li = (double)P.in[I_LIM][gi * 64 + p];
  const double dt = exp((double)P.in[I_LSTEP][gi]);
  const double mag = exp(lr * dt);
  double sn, cs; sincos(li * dt, &sn, &cs);
  const double ar = mag * cs, ai = mag * sn;
  float2* pw = (float2*)(P.ws + OFF_POW) + (size_t)l * (32 * 2 * 64 * 33) + ((size_t)(g * 2 + dir) * 64 + p) * 33;
  double pr = 1.0, pi = 0.0;
  for (int k = 0; k < 33; ++k) {
    pw[k] = make_float2((float)pr, (float)pi);
    double nr = pr * ar - pi * ai, ni = pr * ai + pi * ar; pr = nr; pi = ni;
  }
  const double den = lr * lr + li * li;
  const double cr = ((ar - 1.0) * lr + ai * li) / den, ci = (ai * lr - (ar - 1.0) * li) / den;
  float2* bb = (float2*)(P.ws + OFF_BB) + (size_t)l * (32 * 2 * 64 * 16) + ((size_t)(g * 2 + dir) * 64 + p) * 16;
  for (int j = 0; j < 16; ++j) {
    double br = (double)P.in[I_BRE][(gi * 64 + p) * 16 + j], bi = (double)P.in[I_BIM][(gi * 64 + p) * 16 + j];
    bb[j] = make_float2((float)(cr * br - ci * bi), (float)(cr * bi + ci * br));
  }
}
DI void ph_s5lag(CParams* PP_, int l, char* smem) {
  CParams& P = *launder(PP_);
  const float2* pw = (const float2*)(P.ws + OFF_POW) + (size_t)l * (32 * 2 * 64 * 33);
  const float2* bb = (const float2*)(P.ws + OFF_BB) + (size_t)l * (32 * 2 * 64 * 16);
  float* lag = (float*)(P.ws + OFF_LAG);
  const float* cre_g = P.in[I_CRE]; const float* cim_g = P.in[I_CIM];
  float2* pwS = (float2*)smem;
  float2* bbS = pwS + 64 * 8;
  float2* cS = bbS + 64 * 16;
  const int tid = otid();
  unsigned* qctr = (unsigned*)(P.ws + OFF_BAR) + 3650 + l;
  volatile __attribute__((address_space(3))) unsigned* qslot = (volatile __attribute__((address_space(3))) unsigned*)(smem + SMEM_BYTES + 8);
  for (;;) {
    __syncthreads();
    if (tid == 0) *qslot = __hip_atomic_fetch_add(qctr, 1u, __ATOMIC_RELAXED, __HIP_MEMORY_SCOPE_AGENT);
    __syncthreads();
    const int item = (int)*qslot;
    if (item >= 256) break;
    const int kq = item & 3, dir = (item >> 2) & 1, g = item >> 3;
    const size_t gi = ((size_t)(l * 2 + dir) * 32 + g);
    const size_t gb = (size_t)(g * 2 + dir) * 64;
    for (int i = tid; i < 512; i += NT) { int p = i >> 3, k = i & 7; pwS[i] = pw[(gb + p) * 33 + kq * 8 + k]; }
    for (int i = tid; i < 1024; i += NT) bbS[i] = bb[gb * 16 + i];
    for (int i = tid; i < 1024; i += NT) cS[i] = make_float2(cre_g[gi * 1024 + i], cim_g[gi * 1024 + i]);
    __syncthreads();
    const int kh = tid >> 8, i = (tid >> 4) & 15, j = tid & 15;
    float sm[4];
#pragma unroll
    for (int k = 0; k < 4; ++k) sm[k] = 0.f;
#pragma unroll 4
    for (int p = 0; p < 64; ++p) {
      const float2 c = cS[i * 64 + p]; const float2 b = bbS[p * 16 + j];
      const float cbr = c.x * b.x - c.y * b.y, cbi = c.x * b.y + c.y * b.x;
#pragma unroll
      for (int k = 0; k < 4; ++k) { const float2 a = pwS[p * 8 + kh * 4 + k]; sm[k] += cbr * a.x - cbi * a.y; }
    }
#pragma unroll
    for (int k = 0; k < 4; ++k) lag[(((size_t)(g * 2 + dir) * 32 + kq * 8 + kh * 4 + k) * 16 + i) * 16 + j] = sm[k];
    __syncthreads();
  }
}

DI void ph_s5mats(CParams* PP_, int l) {
  CParams& P = *launder(PP_);
  const float2* pw = (const float2*)(P.ws + OFF_POW) + (size_t)l * (32 * 2 * 64 * 33);
  const float2* bb = (const float2*)(P.ws + OFF_BB) + (size_t)l * (32 * 2 * 64 * 16);
  const float* lag = (const float*)(P.ws + OFF_LAG);
  h16* MQ = (h16*)(P.ws + OFF_MQ);
  h16* PM = (h16*)(P.ws + OFF_P);
  const float* cre_g = P.in[I_CRE]; const float* cim_g = P.in[I_CIM]; const float* s5d = P.in[I_S5D];
  const int NMQ = 32 * 512 * 96, NPM = 32 * 256 * 64;
  for (int t = blockIdx.x * NT + otid(); t < NMQ + NPM; t += gridDim.x * NT) {
    h16x8 o;
    if (t < NMQ) {
      const int g = t / (512 * 96); int rem = t - g * (512 * 96);
      const int n = rem / 96, k8 = (rem - n * 96) * 8;
      const int tt = n >> 4, i = n & 15;
      if (k8 < 512) {
        const int s = k8 >> 4, j0 = k8 & 15;
        const float* lf = lag + ((size_t)(g * 2 + 0) * 32) * 256 + i * 16 + j0;
        const float* lb = lag + ((size_t)(g * 2 + 1) * 32) * 256 + i * 16 + j0;
        float v[8];
        if (s < tt) { const float4 a = *(const float4*)(lf + (tt - s) * 256), b = *(const float4*)(lf + (tt - s) * 256 + 4); v[0]=a.x;v[1]=a.y;v[2]=a.z;v[3]=a.w;v[4]=b.x;v[5]=b.y;v[6]=b.z;v[7]=b.w; }
        else if (s > tt) { const float4 a = *(const float4*)(lb + (s - tt) * 256), b = *(const float4*)(lb + (s - tt) * 256 + 4); v[0]=a.x;v[1]=a.y;v[2]=a.z;v[3]=a.w;v[4]=b.x;v[5]=b.y;v[6]=b.z;v[7]=b.w; }
        else {
          const float4 a = *(const float4*)(lf), b = *(const float4*)(lf + 4), c = *(const float4*)(lb), d = *(const float4*)(lb + 4);
          v[0]=a.x+c.x;v[1]=a.y+c.y;v[2]=a.z+c.z;v[3]=a.w+c.w;v[4]=b.x+d.x;v[5]=b.y+d.y;v[6]=b.z+d.z;v[7]=b.w+d.w;
          const float dd = s5d[l * 512 + g * 16 + i];
#pragma unroll
          for (int e = 0; e < 8; ++e) if (j0 + e == i) v[e] += dd;
        }
#pragma unroll
        for (int e = 0; e < 8; ++e) o[e] = (h16)v[e];
      } else {
        const int kk = k8 - 512, dir = kk >> 7, p0 = (kk >> 1) & 63;
        const int ex = dir ? (32 - tt) : (tt + 1);
        const size_t gi = ((size_t)(l * 2 + dir) * 32 + g);
#pragma unroll
        for (int q = 0; q < 4; ++q) {
          const float cr = cre_g[(gi * 16 + i) * 64 + p0 + q], ci = cim_g[(gi * 16 + i) * 64 + p0 + q];
          const float2 a = pw[((size_t)(g * 2 + dir) * 64 + p0 + q) * 33 + ex];
          o[2 * q] = (h16)(cr * a.x - ci * a.y);
          o[2 * q + 1] = (h16)(-(cr * a.y + ci * a.x));
        }
      }
      *(h16x8*)(MQ + (size_t)t * 8) = o;
    } else {
      const int u = t - NMQ;
      const int g = u / (256 * 64); int rem = u - g * (256 * 64);
      const int n = rem >> 6, k8 = (rem & 63) * 8;
      const int dir = n >> 7, p = (n >> 1) & 63, c = n & 1;
      const int s = k8 >> 4, j0 = k8 & 15;
      const int ex = dir ? s : (31 - s);
      const float2 a = pw[((size_t)(g * 2 + dir) * 64 + p) * 33 + ex];
      const float2* bp = bb + ((size_t)(g * 2 + dir) * 64 + p) * 16 + j0;
#pragma unroll
      for (int e = 0; e < 8; ++e) { const float2 b = bp[e]; o[e] = (h16)(c ? (a.x * b.y + a.y * b.x) : (a.x * b.x - a.y * b.y)); }
      *(h16x8*)(PM + (size_t)u * 8) = o;
    }
  }
}

DI void ph_s5scan(CParams* PP_, int l) {
  CParams& P = *launder(PP_);
  const int tid_s = otid();
  if (tid_s < 384) return;
#pragma unroll 1
  for (int t = blockIdx.x * 128 + (tid_s - 384); t < 32768; t += gridDim.x * 128) {
  const int p = t & 63, dir = (t >> 6) & 1, g = (t >> 7) & 31, b = t >> 12;
  const float2 a32 = ((const float2*)(P.ws + OFF_POW))[(size_t)l * (32 * 2 * 64 * 33) + ((size_t)(g * 2 + dir) * 64 + p) * 33 + 32];
  const h16* S = (const h16*)(P.ws + OFF_S);
  h16* H = (h16*)(P.ws + OFF_HIN);
  float hr = 0.f, hi = 0.f;
  typedef __attribute__((ext_vector_type(2))) _Float16 h16x2_t;
  auto cidx = [&](int it) {
    const int c = (dir == 0) ? it : ((it < 8) ? (7 - it) : (NCH - 1 - (it - 8)));
    return ((size_t)(b * NCH + c) * 32 + g) * 256 + dir * 128 + p * 2;
  };
  unsigned raw[8], nraw[8];
#pragma unroll
  for (int e = 0; e < 8; ++e) raw[e] = *(const unsigned*)(S + cidx(e));
#pragma unroll 1
  for (int it0 = 0; it0 < NCH; it0 += 8) {
    if (it0 + 8 < NCH) {
#pragma unroll
      for (int e = 0; e < 8; ++e) nraw[e] = *(const unsigned*)(S + cidx(it0 + 8 + e));
    }
#pragma unroll
    for (int e = 0; e < 8; ++e) {
      const h16x2_t sv = __builtin_bit_cast(h16x2_t, raw[e]);
      h16x2_t hv; hv[0] = (h16)hr; hv[1] = (h16)hi;
      *(unsigned*)(H + cidx(it0 + e)) = __builtin_bit_cast(unsigned, hv);
      const float nr = a32.x * hr - a32.y * hi + (float)sv[0], ni = a32.x * hi + a32.y * hr + (float)sv[1];
      hr = nr; hi = ni;
    }
#pragma unroll
    for (int e = 0; e < 8; ++e) raw[e] = nraw[e];
  }
  }
}

DI void ph_norm(CParams* PP_, int l, int which) {
  CParams& P = *launder(PP_);
  const int tid_ = otid(); const int lane = tid_ & 63, wid = tid_ >> 6;
  h16* hx = (h16*)(P.ws + OFF_HX);
  const float* mod = (const float*)(P.ws + OFF_MOD);
  const float* gsrc = P.in[which ? I_N2G : I_N1G] + l * 1024;
  const bool from_in = (l == 0 && which == 0);
  const float* src_c = from_in ? P.in[I_CTX] : (const float*)(P.ws + OFF_CTXH);
  const float* src_x = from_in ? P.in[I_X] : (const float*)P.out;
  float4 g4[4];
#pragma unroll
  for (int i = 0; i < 4; ++i) g4[i] = *(const float4*)(gsrc + i * 256 + lane * 4);
  const int stride = gridDim.x * 8;
  int row = blockIdx.x * 8 + wid;
  float4 v[4], nv[4];
  if (row < MTOT) {
    const RowInfo ri = rowinfo(row);
    const float* src = (ri.isctx ? src_c : src_x) + ri.ridx * 1024;
#pragma unroll
    for (int i = 0; i < 4; ++i) v[i] = *(const float4*)(src + i * 256 + lane * 4);
  }
  for (; row < MTOT; row += stride) {
    const RowInfo ri = rowinfo(row);
    const float* sh = mod + (size_t)(l * 9 + ri.mr) * 6144 + (which ? 3 : 0) * 1024;
    const float* scl = sh + 1024;
    if (row + stride < MTOT) {
      const RowInfo rn = rowinfo(row + stride);
      const float* srcn = (rn.isctx ? src_c : src_x) + rn.ridx * 1024;
#pragma unroll
      for (int i = 0; i < 4; ++i) nv[i] = *(const float4*)(srcn + i * 256 + lane * 4);
    }
    float4 s1[4], s0[4];
#pragma unroll
    for (int i = 0; i < 4; ++i) { s1[i] = *(const float4*)(scl + i * 256 + lane * 4); s0[i] = *(const float4*)(sh + i * 256 + lane * 4); }
    float ss = 0.f;
#pragma unroll
    for (int i = 0; i < 4; ++i) ss += v[i].x * v[i].x + v[i].y * v[i].y + v[i].z * v[i].z + v[i].w * v[i].w;
    ss = wave_sum(ss);
    const float rstd = rsqrtf(ss * (1.f / 1024.f) + 1e-6f);
#pragma unroll
    for (int i = 0; i < 4; ++i) {
      const int c = i * 256 + lane * 4;
      h16x4 o;
      o[0] = (h16)(v[i].x * rstd * g4[i].x * (1.f + s1[i].x) + s0[i].x);
      o[1] = (h16)(v[i].y * rstd * g4[i].y * (1.f + s1[i].y) + s0[i].y);
      o[2] = (h16)(v[i].z * rstd * g4[i].z * (1.f + s1[i].z) + s0[i].z);
      o[3] = (h16)(v[i].w * rstd * g4[i].w * (1.f + s1[i].w) + s0[i].w);
      *(h16x4*)(hx + (size_t)row * 1024 + c) = o;
    }
#pragma unroll
    for (int i = 0; i < 4; ++i) v[i] = nv[i];
  }
}
DI void ph_prep(CParams* PP_, int l) {
  CParams& P = *launder(PP_);
  const int tid_ = otid(); const int lane = tid_ & 63, wid = tid_ >> 6;
  h16* px = (h16*)(P.ws + OFF_PX);
  const float* qag = P.in[I_QAG] + l * 384;
  const float* kvag = P.in[I_KVAG] + l * 256;
  const float* sqg = P.in[I_SQKG] + l * 128;
  const int aidx = lane & 31;
  const float freq = exp2f(-(float)(aidx & 15) * (13.287712379549449f / 16.f));
  float gq6[6], gkv4[4];
#pragma unroll
  for (int i = 0; i < 6; ++i) gq6[i] = qag[i * 64 + lane];
#pragma unroll
  for (int i = 0; i < 4; ++i) gkv4[i] = kvag[i * 64 + lane];
  const float gsq = sqg[lane], gsk = sqg[64 + lane];
  const int stride = gridDim.x * 8;
  h16 rq[6], rkv[4], rh[10];
  auto loadrow = [&](int r) {
    const h16* p = px + (size_t)r * PXW;
#pragma unroll
    for (int i = 0; i < 6; ++i) rq[i] = p[PX_QD + i * 64 + lane];
#pragma unroll
    for (int i = 0; i < 4; ++i) rkv[i] = p[PX_KVD + i * 64 + lane];
#pragma unroll
    for (int hh = 0; hh < 10; ++hh) rh[hh] = p[PX_SQ + hh * 64 + lane];
  };
  if (blockIdx.x * 8 + wid < MTOT) loadrow(blockIdx.x * 8 + wid);
  for (int row = blockIdx.x * 8 + wid; row < MTOT; row += stride) {
    h16* pr = px + (size_t)row * PXW;
    const int b = row / NTOK, pos = row - b * NTOK;
    const bool lat = pos >= CTXL;
    const int tpos = pos - CTXL;
    float vq[6], vkv[4], vh[10];
#pragma unroll
    for (int i = 0; i < 6; ++i) vq[i] = (float)rq[i];
#pragma unroll
    for (int i = 0; i < 4; ++i) vkv[i] = (float)rkv[i];
#pragma unroll
    for (int hh = 0; hh < 10; ++hh) vh[hh] = (float)rh[hh];
    if (row + stride < MTOT) loadrow(row + stride);
    float cs = 1.f, sn = 0.f;
    if (lat) { const float ang = (float)((aidx < 16) ? (tpos >> 6) : (tpos & 63)) * freq; sincosf(ang, &sn, &cs); }
    float ssq = 0.f, sskv = 0.f;
#pragma unroll
    for (int i = 0; i < 6; ++i) ssq += vq[i] * vq[i];
#pragma unroll
    for (int i = 0; i < 4; ++i) sskv += vkv[i] * vkv[i];
    float ssh[10];
#pragma unroll
    for (int hh = 0; hh < 10; ++hh) ssh[hh] = vh[hh] * vh[hh];
#pragma unroll
    for (int o = 32; o > 0; o >>= 1) {
      const float t0 = shx(ssq, o, lane), t1 = shx(sskv, o, lane);
      float tt[10];
#pragma unroll
      for (int hh = 0; hh < 10; ++hh) tt[hh] = shx(ssh[hh], o, lane);
      ssq += t0; sskv += t1;
#pragma unroll
      for (int hh = 0; hh < 10; ++hh) ssh[hh] += tt[hh];
    }
    const float rq = rsqrtf(ssq * (1.f / 384.f) + 1e-6f), rkv = rsqrtf(sskv * (1.f / 256.f) + 1e-6f);
#pragma unroll
    for (int i = 0; i < 6; ++i) pr[PX_QD + i * 64 + lane] = (h16)(vq[i] * rq * gq6[i]);
#pragma unroll
    for (int i = 0; i < 4; ++i) pr[PX_KVD + i * 64 + lane] = (h16)(vkv[i] * rkv * gkv4[i]);
#pragma unroll
    for (int hh = 0; hh < 10; ++hh) {
      const float rstd = rsqrtf(ssh[hh] * (1.f / 64.f) + 1e-6f);
      const float vn = vh[hh] * rstd * ((hh < 8) ? gsq : gsk);
      const float partner = shx(vn, 32, lane);
      const float o = (lane < 32) ? (vn * cs - partner * sn) : (vn * cs + partner * sn);
      pr[PX_SQ + hh * 64 + lane] = (h16)o;
    }
  }
}

DI void ph_final(CParams* PP_, int l) {
  CParams& P = *launder(PP_);
  const int tid_ = otid(); const int lane = tid_ & 63, wid = tid_ >> 6;
  h16* qkv = (h16*)(P.ws + OFF_QKV);
  const h16* px = (const h16*)(P.ws + OFF_PX);
  const float* gq = P.in[I_MQKG] + l * 192;
  const float* gk = gq + 96;
  const int aidx = lane & 15;
  const float freq = exp2f(-(float)(aidx & 7) * (13.287712379549449f / 8.f));
  const float gq0 = gq[lane], gk0 = gk[lane];
  const float gq1 = (lane < 32) ? gq[64 + lane] : 0.f, gk1 = (lane < 32) ? gk[64 + lane] : 0.f;
  const int stride = gridDim.x * 6;
  h16 r0[16], r1[8], rk;
  auto loadrow = [&](int r) {
    const h16* q = qkv + (size_t)r * QKVW;
    rk = (lane < 32) ? px[(size_t)r * PXW + PX_KR + lane] : (h16)0.f;
#pragma unroll
    for (int hh = 0; hh < 16; ++hh) r0[hh] = q[hh * 96 + lane];
#pragma unroll
    for (int hh = 0; hh < 8; ++hh) r1[hh] = (lane < 32) ? q[hh * 96 + 64 + lane] : (h16)0.f;
  };
  if (wid < 6 && blockIdx.x * 6 + wid < MTOT) loadrow(blockIdx.x * 6 + wid);
  for (int row = (wid < 6) ? (int)(blockIdx.x * 6 + wid) : MTOT; row < MTOT; row += stride) {
    h16* qr = qkv + (size_t)row * QKVW;
    const int b = row / NTOK, pos = row - b * NTOK;
    const bool lat = pos >= CTXL;
    const int tpos = pos - CTXL;
    float v0[16], v1[8];
    const float kpe = (float)rk;
#pragma unroll
    for (int hh = 0; hh < 16; ++hh) v0[hh] = (float)r0[hh];
#pragma unroll
    for (int hh = 0; hh < 8; ++hh) v1[hh] = (float)r1[hh];
    if (row + stride < MTOT) loadrow(row + stride);
    float cs = 1.f, sn = 0.f;
    if (lat) { const float ang = (float)((aidx < 8) ? (tpos >> 6) : (tpos & 63)) * freq; sincosf(ang, &sn, &cs); }
    float ss[16];
#pragma unroll
    for (int hh = 0; hh < 16; ++hh) { const float w1 = (hh < 8) ? v1[hh] : kpe; ss[hh] = v0[hh] * v0[hh] + w1 * w1; }
#pragma unroll
    for (int o = 32; o > 0; o >>= 1) {
      float tt[16];
#pragma unroll
      for (int hh = 0; hh < 16; ++hh) tt[hh] = shx(ss[hh], o, lane);
#pragma unroll
      for (int hh = 0; hh < 16; ++hh) ss[hh] += tt[hh];
    }
#pragma unroll
    for (int hh = 0; hh < 16; ++hh) {
      const bool isk = hh >= 8;
      const float rstd = rsqrtf(ss[hh] * (1.f / 96.f) + 1e-6f);
      const float o0 = v0[hh] * rstd * (isk ? gk0 : gq0);
      const float w1 = isk ? kpe : v1[hh & 7];
      const float v1n = w1 * rstd * (isk ? gk1 : gq1);
      const float partner = shx(v1n, 16, lane);
      const float o1 = ((lane & 16) == 0) ? (v1n * cs - partner * sn) : (v1n * cs + partner * sn);
      qr[hh * 96 + lane] = (h16)o0;
      if (lane < 32) qr[hh * 96 + 64 + lane] = (h16)o1;
    }
  }
}

template <int DQK>
DI void attn_block(const h16* __restrict__ Q, int ldq, const h16* __restrict__ Kb, int ldk,
                           const h16* __restrict__ Vb, int ldv, h16* __restrict__ O, int ldo,
                           int ntiles, int na, int t0b, int qpos0, const float* sinkv, bool has_sink, float scale_l2, char* smem, bool gqa = false) {
  constexpr int KS = DQK + 8;
  constexpr int NKCH = 64 * (DQK / 8);
  constexpr int NKC = (NKCH + NT - 1) / NT;
  constexpr int CPK = DQK / 8;
  constexpr int VS = 96;
  constexpr int HB = 64 * KS + 64 * VS;
  typedef short v4s_t __attribute__((__vector_size__(4 * sizeof(short))));
  h16* const buf0 = (h16*)smem;
  const int tid = otid(), lane = tid & 63, wid = tid >> 6, lr = lane & 31, lh = lane >> 5;
  const int qrow_w = gqa ? ((wid & 1) * 32) : (wid * 32);
  const int qcol_w = gqa ? ((wid >> 1) * 64) : 0;
  const float sink_l2 = has_sink ? sinkv[gqa ? (wid >> 1) : 0] * 1.4426950408889634f : 0.f;
  h16x8 qf[DQK / 16];
  {
    const h16* qp = Q + (size_t)(qrow_w + lr) * ldq + qcol_w + lh * 8;
#pragma unroll
    for (int ks = 0; ks < DQK / 16; ++ks) qf[ks] = *(const h16x8*)(qp + ks * 16);
  }
  f32x16 o[2];
  float m, lsum;
  u32x4 kreg[NKC], vreg[1];
#pragma unroll 1
  for (int rep = 0; rep < REPA; ++rep) {
#pragma unroll
  for (int d = 0; d < 2; ++d)
#pragma unroll
    for (int i = 0; i < 16; ++i) o[d][i] = 0.f;
  m = has_sink ? sink_l2 : -1e30f;
  lsum = (has_sink && lh == 0) ? 1.f : 0.f;
  const bool full = (rep == REPA - 1);
  const bool do_qk = full || (PMODE & 1), do_sm = full || (PMODE & 2), do_pv = full || (PMODE & 4);
  auto load_tile = [&](int it) {
    const int kp0 = ((it < na) ? it : (t0b + (it - na))) * 64;
#pragma unroll
    for (int i = 0; i < NKC; ++i) { int c = tid + NT * i; if (c < NKCH) { int key = c / CPK, dc = c - key * CPK; kreg[i] = *(const u32x4*)(Kb + (size_t)(kp0 + key) * ldk + dc * 8); } }
    { int key = tid >> 3, dvc = tid & 7; vreg[0] = *(const u32x4*)(Vb + (size_t)(kp0 + key) * ldv + dvc * 8); }
  };
  auto store_tile = [&](h16* Ksd) {
    h16* Vtd = Ksd + 64 * KS;
#pragma unroll
    for (int i = 0; i < NKC; ++i) { int c = tid + NT * i; if (c < NKCH) { int key = c / CPK, dc = c - key * CPK; *(u32x4*)(Ksd + key * KS + dc * 8) = kreg[i]; } }
    { int key = tid >> 3, dvc = tid & 7; *(u32x4*)(Vtd + key * VS + dvc * 8) = vreg[0]; }
  };
  auto qk = [&](f32x16 (&sd)[2], const h16* Ksrc) {
    h16x8 kf[2][DQK / 16];
#pragma unroll
    for (int ks = 0; ks < DQK / 16; ++ks)
#pragma unroll
      for (int kt = 0; kt < 2; ++kt) kf[kt][ks] = *(const h16x8*)(Ksrc + (kt * 32 + lr) * KS + ks * 16 + lh * 8);
    const f32x16 zv = {0.f, 0.f, 0.f, 0.f, 0.f, 0.f, 0.f, 0.f, 0.f, 0.f, 0.f, 0.f, 0.f, 0.f, 0.f, 0.f};
#pragma unroll
    for (int kt = 0; kt < 2; ++kt) sd[kt] = __builtin_amdgcn_mfma_f32_32x32x16_f16(kf[kt][0], qf[0], zv, 0, 0, 0);
#pragma unroll
    for (int ks = 1; ks < DQK / 16; ++ks)
#pragma unroll
      for (int kt = 0; kt < 2; ++kt) sd[kt] = __builtin_amdgcn_mfma_f32_32x32x16_f16(kf[kt][ks], qf[ks], sd[kt], 0, 0, 0);
  };
  load_tile(0);
  store_tile(buf0);
  if (ntiles > 1) { load_tile(1); store_tile(buf0 + HB); }
  __syncthreads();
  if (ntiles > 2) load_tile(2);
  f32x16 s[2], sn[2];
#pragma unroll
  for (int kt = 0; kt < 2; ++kt)
#pragma unroll
    for (int i = 0; i < 16; ++i) { s[kt][i] = 0.f; sn[kt][i] = 0.f; }
  const int wid_u = __builtin_amdgcn_readfirstlane(wid);
  auto tclass = [&](int it) -> int {
    if (it < na) return 1;
    const int klo = (t0b + (it - na)) * 64 - CTXL, khi = klo + 63;
    const int qlo = qpos0 + (gqa ? ((wid_u & 1) * 32) : (wid_u * 32)), qhi = qlo + 31;
    if (khi < qlo - 128 || klo > qhi + 128) return 0;
    if (klo >= qhi - 128 && khi <= qlo + 128) return 1;
    return 2;
  };
  int bcur = 0;
#pragma unroll 1
  for (int it = 0; it < ntiles; ++it) {
    const int bnext = (bcur == 2) ? 0 : bcur + 1;
    const int bfree = (bnext == 2) ? 0 : bnext + 1;
    const h16* Vt = buf0 + bcur * HB + 64 * KS;
    const int cls = tclass(it);
    if (cls != 0) {
    qk(s, buf0 + bcur * HB);
    h16x8 vfr[2][2][2];
    if (do_pv) {
#pragma unroll
      for (int kt = 0; kt < 2; ++kt)
#pragma unroll
        for (int st = 0; st < 2; ++st)
#pragma unroll
          for (int d = 0; d < 2; ++d) {
            const h16* vp = Vt + (kt * 32 + st * 16 + 4 * lh + ((lane >> 2) & 3)) * VS + d * 32 + 16 * ((lane >> 4) & 1) + 4 * (lane & 3);
            const v4s_t lo = __builtin_amdgcn_ds_read_tr16_b64_v4i16((__attribute__((address_space(3))) v4s_t*)vp);
            const v4s_t hi = __builtin_amdgcn_ds_read_tr16_b64_v4i16((__attribute__((address_space(3))) v4s_t*)(vp + 8 * VS));
            vfr[kt][st][d] = __builtin_bit_cast(h16x8, __builtin_shufflevector(lo, hi, 0, 1, 2, 3, 4, 5, 6, 7));
          }
    }
    if (do_sm) {
    if (cls == 2) {
      const int kl0 = (t0b + (it - na)) * 64 - CTXL;
      const int qp = qpos0 + qrow_w + lr;
      const int dq = qp - kl0 - 4 * lh;
#pragma unroll
      for (int kt = 0; kt < 2; ++kt)
#pragma unroll
        for (int i = 0; i < 16; ++i) { const int d = dq - (kt * 32 + (i & 3) + 8 * (i >> 2)); if (d > 128 || d < -128) s[kt][i] = -3.0e38f; }
    }
    float mx = -3.0e38f;
#pragma unroll
    for (int kt = 0; kt < 2; ++kt)
#pragma unroll
      for (int i = 0; i < 16; ++i) mx = fmaxf(mx, s[kt][i]);
    if (__builtin_amdgcn_ballot_w64(mx * scale_l2 > m + 8.f) != 0ull) {
      mx = fmaxf(mx, shx(mx, 32, lane));
      const float mn = fmaxf(m, mx * scale_l2);
      const float alpha = __builtin_amdgcn_exp2f(m - mn);
      m = mn;
      lsum *= alpha;
#pragma unroll
      for (int d = 0; d < 2; ++d)
#pragma unroll
        for (int i = 0; i < 16; ++i) o[d][i] *= alpha;
    }
    typedef float f32x2_t __attribute__((ext_vector_type(2)));
    f32x2_t ps2 = {0.f, 0.f};
    const f32x2_t sc2 = {scale_l2, scale_l2}, nm2 = {-m, -m};
#pragma unroll
    for (int kt = 0; kt < 2; ++kt)
#pragma unroll
      for (int i = 0; i < 16; i += 2) {
        f32x2_t t = {s[kt][i], s[kt][i + 1]};
        t = t * sc2 + nm2;
        f32x2_t pv; pv.x = __builtin_amdgcn_exp2f(t.x); pv.y = __builtin_amdgcn_exp2f(t.y);
        s[kt][i] = pv.x; s[kt][i + 1] = pv.y; ps2 += pv;
      }
    lsum += ps2.x + ps2.y;
    }
    if (do_pv) {
#pragma unroll
    for (int kt = 0; kt < 2; ++kt)
#pragma unroll
      for (int st = 0; st < 2; ++st) {
        h16x8 pf;
#pragma unroll
        for (int j = 0; j < 8; ++j) pf[j] = (h16)s[kt][8 * st + j];
#pragma unroll
        for (int d = 0; d < 2; ++d) {
          const h16x8 va = vfr[kt][st][d];
          o[d] = __builtin_amdgcn_mfma_f32_32x32x16_f16(va, pf, o[d], 0, 0, 0);
        }
      }
    }
    }
    if (it + 2 < ntiles) store_tile(buf0 + bfree * HB);
    __syncthreads();
    if (it + 3 < ntiles) load_tile(it + 3);
    bcur = bnext;
  }
  if (!full) {
#pragma unroll
    for (int d = 0; d < 2; ++d)
#pragma unroll
      for (int i = 0; i < 16; ++i) { asm volatile("" :: "v"(o[d][i])); asm volatile("" :: "v"(s[d][i])); }
    asm volatile("" :: "v"(lsum), "v"(m));
  }
  }
  const float lt = lsum + shx(lsum, 32, lane);
  const float inv = 1.f / lt;
  h16* op = O + (size_t)(qrow_w + lr) * ldo + qcol_w;
#pragma unroll
  for (int d = 0; d < 2; ++d)
#pragma unroll
    for (int g4 = 0; g4 < 4; ++g4) {
      h16x4 w;
#pragma unroll
      for (int j = 0; j < 4; ++j) w[j] = (h16)(o[d][g4 * 4 + j] * inv);
      *(h16x4*)(op + d * 32 + g4 * 8 + lh * 4) = w;
    }
  __syncthreads();
}

#define XB_TMO      128
#define XB_XCNT(j)  (256  + 64 * (j))
#define XB_XSUB(j)  (1280 + 64 * (j))
#define XB_XGEN(j)  (2304 + 64 * (j))
#define XB_TOP      3328
#define XB_TOPGEN   3392
#define XCD_BAR_WORDS 3456
#define XB_SPIN_CAP (1u << 20)
#define LAS __attribute__((address_space(3)))
DI unsigned xb_ld(unsigned* p)              { return __hip_atomic_load(p, __ATOMIC_RELAXED, __HIP_MEMORY_SCOPE_AGENT); }
DI unsigned xb_add(unsigned* p, unsigned v) { return __hip_atomic_fetch_add(p, v, __ATOMIC_RELAXED, __HIP_MEMORY_SCOPE_AGENT); }
DI unsigned xb_xcc_id() { return (unsigned)__builtin_amdgcn_s_getreg((3 << 11) | 20) & 0xFu; }
#define XB_SPIN(cond, bar) do { unsigned _sp = 0; while (cond) { __builtin_amdgcn_s_sleep(1); \
    if ((++_sp & 255u) == 0u) { if (xb_ld(&(bar)[XB_TMO])) break; if (_sp > XB_SPIN_CAP) { atomicAdd(&(bar)[XB_TMO], 1u); break; } } } } while (0)
struct XcdBarrier { unsigned* bar; unsigned x; volatile LAS unsigned* st; };
DI XcdBarrier xcd_barrier_post(unsigned* bar, volatile LAS unsigned* st) {
  XcdBarrier b; b.bar = bar; b.x = xb_xcc_id(); b.st = st;
  if (threadIdx.x == 0) (void)xb_add(&bar[XB_XCNT(b.x)], 1u);
  return b;
}
DI void xcd_barrier_complete(unsigned* bar, unsigned x, unsigned& nloc, unsigned& nx) {
  const unsigned G = gridDim.x * gridDim.y * gridDim.z;
  unsigned sum, cnt, mine, sp = 0u;
  for (;;) {
    sum = 0u; cnt = 0u; mine = 0u;
#pragma unroll
    for (unsigned j = 0; j < 16; ++j) { const unsigned c = xb_ld(&bar[XB_XCNT(j)]); sum += c; cnt += (c > 0u) ? 1u : 0u; mine = (j == x) ? c : mine; }
    if (sum == G) break;
    __builtin_amdgcn_s_sleep(1);
    if ((++sp & 255u) == 0u) { if (xb_ld(&bar[XB_TMO])) break; if (sp > XB_SPIN_CAP) { atomicAdd(&bar[XB_TMO], 1u); break; } }
  }
  nloc = mine > 0u ? mine : 1u; nx = cnt > 0u ? cnt : 1u;
}
DI void xcd_barrier(CParams* PP_, volatile LAS unsigned* st) {
  XcdBarrier b; b.bar = (unsigned*)(launder(PP_)->ws + OFF_BAR); b.x = xb_xcc_id(); b.st = st;
  asm volatile("s_waitcnt vmcnt(0)" ::: "memory");
  __syncthreads();
  if (threadIdx.x == 0) {
    unsigned* bar = b.bar;
    __builtin_amdgcn_s_waitcnt(0);
    unsigned nloc = b.st[0], nx = b.st[1];
    if (nloc == 0u) { xcd_barrier_complete(bar, b.x, nloc, nx); b.st[0] = nloc; b.st[1] = nx; }
    const unsigned old = xb_add(&bar[XB_XSUB(b.x)], 1u);
    const unsigned gen = old / nloc;
    if (old + 1u == (gen + 1u) * nloc) {
      __builtin_amdgcn_fence(__ATOMIC_RELEASE, "agent");
      asm volatile("s_waitcnt vmcnt(0)" ::: "memory");
      const unsigned og = xb_add(&bar[XB_TOP], 1u);
      const unsigned tg = og / nx;
      if (og + 1u == (tg + 1u) * nx) xb_add(&bar[XB_TOPGEN], 1u);
      else XB_SPIN(xb_ld(&bar[XB_TOPGEN]) == tg, bar);
      __builtin_amdgcn_fence(__ATOMIC_ACQUIRE, "agent");
      xb_add(&bar[XB_XGEN(b.x)], 1u);
      asm volatile("s_waitcnt vmcnt(0)" ::: "memory");
    } else {
      XB_SPIN(xb_ld(&bar[XB_XGEN(b.x)]) == gen, bar);
      __builtin_amdgcn_fence(__ATOMIC_ACQUIRE, "agent");
      asm volatile("s_waitcnt vmcnt(0)" ::: "memory");
    }
  }
  __syncthreads();
}

namespace pg8 {
constexpr int BM = 256, BK = 64, HALF = 128, HTB = HALF * BK * 2, NXCD = 8, WGM = 8;
DI int lds_byte(int r, int c) { const int st = (r >> 4) * 2 + (c >> 5), rr = r & 15, cc = c & 31, ob = rr * 64 + cc * 2; return st * 1024 + (ob ^ (((ob >> 9) & 1) << 5)); }
DI void stage_rc(int b, int& R, int& C) { const int st = b / 1024, sb = b % 1024, swz = sb ^ (((sb >> 9) & 1) << 5); R = (st >> 1) * 16 + swz / 64; C = (st & 1) * 32 + (swz % 64) / 2; }
DI int perm32(int rho) { const int n = rho >> 4, i = rho & 15; return 8 * (i >> 2) + 4 * n + (i & 3); }
struct Unit { int pm, pn, seg; };
DI bool next_unit(int i, int G, int c, int nM, int nN, bool lat, int nseg, Unit& u) {
  if (lat) nM = 128;
  const int nwg = nM * nN;
  const int ib = i / nseg; u.seg = i - ib * nseg;
  const long L = (long)ib * G + c; if (L >= nwg) return false;
  int wgid = (int)L; { const int q = nwg / NXCD, r = nwg % NXCD, xcd = wgid % NXCD, off = wgid / NXCD; wgid = (xcd < r ? xcd * (q + 1) : r * (q + 1) + (xcd - r) * q) + off; }
  const int nig = WGM * nN, gid = wgid / nig, fm = gid * WGM, gsz = (nM - fm) < WGM ? (nM - fm) : WGM;
  u.pm = fm + ((wgid % nig) % gsz); u.pn = (wgid % nig) / gsz;
  if (lat) u.pm = u.pm + (u.pm >> 4) + 1;
  return true;
}
typedef float f32x4 __attribute__((ext_vector_type(4)));

template <bool PERM, class Epi>
DI void gemm_fast(LAS unsigned char* lds, const h16* A, int lda, const h16* Bt, int K, int nM, int nN, const Epi& E, bool lat = false,
                   int nseg = 1, int segA0 = 0, int segA1 = 0, int segA2 = 0, size_t segB = 0) {
  const int tid = otid(), wid = __builtin_amdgcn_readfirstlane(tid >> 6), lane = tid & 63, wr = wid >> 2, wc = wid & 3, fr = lane & 15, fq = lane >> 4;
  const int nt = K / BK;
  const int G = gridDim.x, cblk = blockIdx.x;
  unsigned voffA[2], voffB[2];
#pragma unroll
  for (int i = 0; i < 2; ++i) { int R, C; stage_rc(tid * 16 + i * 8192, R, C); const int Rb = PERM ? ((R & ~31) + perm32(R & 31)) : R;
    voffA[i] = (unsigned)(R * lda + C) * 2u; voffB[i] = (unsigned)(Rb * K + C) * 2u; }
  const size_t kstep = (size_t)(BK * 2);
  const size_t hstepA = (size_t)HALF * lda * 2, hstepB = (size_t)HALF * K * 2;
  const size_t tstepA = 2 * hstepA, tstepB = 2 * hstepB;
  const unsigned ldsw = (unsigned)wid * 1024u;
  const int aoff = lds_byte(wr * 64 + fr, fq * 8), boff = lds_byte(wc * 32 + fr, fq * 8);
#define PG8_SA(b, h) (((b) * 2 + (h)) * HTB)
#define PG8_SB(b, h) ((4 + (b) * 2 + (h)) * HTB)
#define PG8_STAGE(bufoff, gbase, voff) do { _Pragma("unroll") for (int _i = 0; _i < 2; ++_i) \
    __builtin_amdgcn_global_load_lds((const unsigned*)((const char*)(gbase) + (voff)[_i]), (LAS unsigned*)(lds + (bufoff) + ldsw + _i * 8192), 16, 0, 0); } while (0)
#define PG8_LDA(dst, b, h) do { _Pragma("unroll") for (int m = 0; m < 4; ++m) _Pragma("unroll") for (int k = 0; k < 2; ++k) dst[m][k] = *(const LAS h16x8*)(lds + PG8_SA(b, h) + aoff + m * 2048 + k * 1024); } while (0)
#define PG8_LDB(dst, b, h) do { _Pragma("unroll") for (int n = 0; n < 2; ++n) _Pragma("unroll") for (int k = 0; k < 2; ++k) dst[n][k] = *(const LAS h16x8*)(lds + PG8_SB(b, h) + boff + n * 2048 + k * 1024); } while (0)
#define PG8_MMA(ai, bj, At, Bt_) do { __builtin_amdgcn_s_setprio(1); _Pragma("unroll") for (int m = 0; m < 4; ++m) _Pragma("unroll") for (int n = 0; n < 2; ++n) _Pragma("unroll") for (int k = 0; k < 2; ++k) \
    acc[ai][bj][m][n] = __builtin_amdgcn_mfma_f32_16x16x32_f16(Bt_[n][k], At[m][k], acc[ai][bj][m][n], 0, 0, 0); __builtin_amdgcn_s_setprio(0); } while (0)
#define PG8_WAIT_V(n) asm volatile("s_waitcnt vmcnt(" #n ")" ::: "memory")
#define PG8_WAIT_L(n) asm volatile("s_waitcnt lgkmcnt(" #n ")" ::: "memory")
#define PG8_BAR __builtin_amdgcn_s_barrier()
#define PG8_SCHED __builtin_amdgcn_sched_barrier(0)
  Unit cur, nxt; int ui = 0;
  if (!next_unit(0, G, cblk, nM, nN, lat, nseg, cur)) return;
  auto sa = [&](int sg) { return (size_t)(sg == 0 ? segA0 : (sg == 1 ? segA1 : segA2)); };
  f32x4 acc[2][2][4][2];
#pragma unroll
  for (int a = 0; a < 2; ++a)
#pragma unroll
    for (int b = 0; b < 2; ++b)
#pragma unroll
      for (int m = 0; m < 4; ++m)
#pragma unroll
        for (int n = 0; n < 2; ++n) acc[a][b][m][n] = (f32x4){0.f, 0.f, 0.f, 0.f};
  h16x8 At[4][2], B0[2][2], B1[2][2];
  const char* cA = (const char*)A + sa(cur.seg) + (size_t)cur.pm * tstepA; const char* cB = (const char*)Bt + cur.seg * segB + (size_t)cur.pn * tstepB;
  PG8_STAGE(PG8_SB(0, 0), cB, voffB); PG8_STAGE(PG8_SA(0, 0), cA, voffA); PG8_STAGE(PG8_SB(0, 1), cB + hstepB, voffB); PG8_STAGE(PG8_SA(0, 1), cA + hstepA, voffA);
  if (wr == 1) PG8_BAR;
  PG8_WAIT_V(4); PG8_BAR;
  PG8_STAGE(PG8_SB(1, 0), cB + kstep, voffB); PG8_STAGE(PG8_SA(1, 0), cA + kstep, voffA); PG8_STAGE(PG8_SB(1, 1), cB + hstepB + kstep, voffB);
  PG8_WAIT_V(6); PG8_BAR;
  for (;;) {
    const bool has_next = next_unit(ui + 1, G, cblk, nM, nN, lat, nseg, nxt);
    const char* nA = has_next ? (const char*)A + sa(nxt.seg) + (size_t)nxt.pm * tstepA : cA; const char* nB = has_next ? (const char*)Bt + nxt.seg * segB + (size_t)nxt.pn * tstepB : cB;
    for (int t = 0; t < nt; t += 2) {
      const bool last = (t == nt - 2);
      const char* a1 = cA + (size_t)(t + 1) * kstep;
      const char* a2 = last ? nA : cA + (size_t)(t + 2) * kstep; const char* b2 = last ? nB : cB + (size_t)(t + 2) * kstep;
      const char* a3 = a2 + kstep; const char* b3 = b2 + kstep;
      PG8_LDB(B0, 0, 0); PG8_SCHED; PG8_LDA(At, 0, 0); PG8_STAGE(PG8_SA(1, 1), a1 + hstepA, voffA);
      PG8_WAIT_L(8); PG8_BAR; PG8_WAIT_L(0); PG8_MMA(0, 0, At, B0); PG8_BAR; PG8_SCHED;
      PG8_LDB(B1, 0, 1); PG8_STAGE(PG8_SB(0, 0), b2, voffB);
      PG8_BAR; PG8_WAIT_L(0); PG8_MMA(0, 1, At, B1); PG8_BAR;
      PG8_LDA(At, 0, 1); PG8_STAGE(PG8_SA(0, 0), a2, voffA);
      PG8_BAR; PG8_WAIT_L(0); PG8_MMA(1, 0, At, B0); PG8_BAR; PG8_SCHED;
      PG8_STAGE(PG8_SB(0, 1), b2 + hstepB, voffB);
      PG8_WAIT_V(6); PG8_BAR; PG8_MMA(1, 1, At, B1); PG8_BAR;
      PG8_LDB(B0, 1, 0); PG8_SCHED; PG8_LDA(At, 1, 0); PG8_STAGE(PG8_SA(0, 1), a2 + hstepA, voffA);
      PG8_WAIT_L(8); PG8_BAR; PG8_WAIT_L(0); PG8_MMA(0, 0, At, B0); PG8_BAR; PG8_SCHED;
      PG8_LDB(B1, 1, 1); PG8_STAGE(PG8_SB(1, 0), b3, voffB);
      PG8_BAR; PG8_WAIT_L(0); PG8_MMA(0, 1, At, B1); PG8_BAR;
      PG8_LDA(At, 1, 1); PG8_STAGE(PG8_SA(1, 0), a3, voffA);
      PG8_BAR; PG8_WAIT_L(0); PG8_MMA(1, 0, At, B0); PG8_BAR; PG8_SCHED;
      PG8_STAGE(PG8_SB(1, 1), b3 + hstepB, voffB);
      PG8_WAIT_V(6); PG8_BAR; PG8_MMA(1, 1, At, B1); PG8_BAR;
    }
    { const int et = otid(); const int ew = et >> 6, el = et & 63; E(acc, cur, ew >> 2, ew & 3, el & 15, el >> 4); }
    if (!has_next) break;
#pragma unroll
    for (int a = 0; a < 2; ++a)
#pragma unroll
      for (int b = 0; b < 2; ++b)
#pragma unroll
        for (int m = 0; m < 4; ++m)
#pragma unroll
          for (int n = 0; n < 2; ++n) acc[a][b][m][n] = (f32x4){0.f, 0.f, 0.f, 0.f};
    cur = nxt; cA = nA; cB = nB; ++ui;
  }
  PG8_WAIT_V(0);
  if (wr == 0) PG8_BAR;
  PG8_BAR;
#undef PG8_SA
#undef PG8_SB
#undef PG8_STAGE
#undef PG8_LDA
#undef PG8_LDB
#undef PG8_MMA
#undef PG8_WAIT_V
#undef PG8_WAIT_L
#undef PG8_BAR
#undef PG8_SCHED
}
template <class F>
DI void epi8(const f32x4 (&acc)[2][2][4][2], const Unit& u, int wr, int wc, int fr, int fq, F fn) {
#pragma unroll
  for (int ai = 0; ai < 2; ++ai)
#pragma unroll
    for (int m = 0; m < 4; ++m) {
      const int row = u.pm * BM + ai * HALF + wr * 64 + m * 16 + fr;
#pragma unroll
      for (int bj = 0; bj < 2; ++bj) fn(row, u.pn * BM + bj * HALF + wc * 32 + 8 * fq, acc[ai][bj][m][0], acc[ai][bj][m][1]);
    }
}
DI h16x8 pack8(f32x4 lo, f32x4 hi) { h16x8 o; o[0] = (h16)lo[0]; o[1] = (h16)lo[1]; o[2] = (h16)lo[2]; o[3] = (h16)lo[3]; o[4] = (h16)hi[0]; o[5] = (h16)hi[1]; o[6] = (h16)hi[2]; o[7] = (h16)hi[3]; return o; }
}
using pg8::f32x4;

DI void ph_gemm_in(CParams* PP_, char* smem) {
  CParams& P = *launder(PP_);
  const h16* hx = (const h16*)(P.ws + OFF_HX);
  const h16* W = (const h16*)(P.ws + OFF_W16) + WO_IN;
  h16* px = (h16*)(P.ws + OFF_PX);
  auto E = [=](const f32x4 (&acc)[2][2][4][2], const pg8::Unit& u, int wr, int wc, int fr, int fq) {
    pg8::epi8(acc, u, wr, wc, fr, fq, [=](int row, int col, f32x4 lo, f32x4 hi) { *(h16x8*)(px + (size_t)row * PXW + col) = pg8::pack8(lo, hi); });
  };
  pg8::gemm_fast<true>((LAS unsigned char*)smem, hx, 1024, W, 1024, 136, 8, E);
}
DI void ph_upproj(CParams* PP_, int l, char* smem) {
  CParams& P = *launder(PP_);
  const h16* W = (const h16*)(P.ws + OFF_W16);
  h16* px = (h16*)(P.ws + OFF_PX);
  h16* qkv = (h16*)(P.ws + OFF_QKV);
  h16* S = (h16*)(P.ws + OFF_S);
  const h16* PM = (const h16*)(P.ws + OFF_P);
  {
    auto E = [=](const f32x4 (&acc)[2][2][4][2], const pg8::Unit& u, int wr, int wc, int fr, int fq) {
      pg8::epi8(acc, u, wr, wc, fr, fq, [=](int row, int col, f32x4 lo, f32x4 hi) { *(h16x8*)(qkv + (size_t)row * QKVW + col) = pg8::pack8(lo, hi); });
    };
    pg8::gemm_fast<true>((LAS unsigned char*)smem, px + PX_QD, PXW, W + WO_UQ, 384, 136, 3, E);
  }
  {
    auto E = [=](const f32x4 (&acc)[2][2][4][2], const pg8::Unit& u, int wr, int wc, int fr, int fq) {
      pg8::epi8(acc, u, wr, wc, fr, fq, [=](int row, int n, f32x4 lo, f32x4 hi) {
        const int hh = n >> 7, e = n & 127;
        const int col = (e < 64) ? (768 + hh * 96 + e) : (1536 + hh * 64 + (e - 64));
        *(h16x8*)(qkv + (size_t)row * QKVW + col) = pg8::pack8(lo, hi);
      });
    };
    pg8::gemm_fast<true>((LAS unsigned char*)smem, px + PX_KVD, PXW, W + WO_UKV, 256, 136, 4, E);
  }
  __syncthreads();
  const int tid = otid();
  const int half = tid >> 8;
  unsigned* qctr = (unsigned*)(P.ws + OFF_BAR) + 3610 + l;
  volatile LAS unsigned* qslot = (volatile LAS unsigned*)(smem + SMEM_BYTES + 8);
  for (;;) {
    __syncthreads();
    if (tid == 0) *qslot = __hip_atomic_fetch_add(qctr, 1u, __ATOMIC_RELAXED, __HIP_MEMORY_SCOPE_AGENT);
    __syncthreads();
    const int pr = (int)*qslot;
    if (pr >= 288) break;
    const int tt = pr * 2 + half; const int g = tt / 18; const int r2 = tt % 18; const int m0 = (r2 >> 1) * 128, n0 = (r2 & 1) * 128;
    f32x16 acc[2][2];
    gemm_core<2>(acc, [=](int r, int k) { int cc = m0 + r; if (cc > NCHT - 1) cc = NCHT - 1; return px + (size_t)(cc * 32 + (k >> 4)) * PXW + PX_U + g * 16 + (k & 15); },
                 PM + ((size_t)g * 256 + n0) * 512, 512, 512, smem);
    gemm_epi<2>(acc, [=](int r, int c, float v) { const int cc = m0 + r; if (cc < NCHT) S[((size_t)cc * 32 + g) * 256 + n0 + c] = (h16)v; });
  }
  __syncthreads();
}
DI void ph_mix(CParams* PP_, int l, char* smem) {
  CParams& P = *launder(PP_);
  h16* px = (h16*)(P.ws + OFF_PX);
  const h16* qkv = (const h16*)(P.ws + OFF_QKV);
  const h16* MQ = (const h16*)(P.ws + OFF_MQ);
  const h16* HIN = (const h16*)(P.ws + OFF_HIN);
  h16* yact = (h16*)(P.ws + OFF_YACT);
  const float* sinkp = P.in[I_SINK];
  const float L2E = 1.4426950408889634f;
  constexpr int NA = NB * 8 * 17;
  auto run_mla = [&](int h, int b, int qt) {
    const size_t row0 = (size_t)b * NTOK + qt * 256;
    const size_t brow = (size_t)b * NTOK;
    const int ntiles = (qt < 1) ? 4 : 68;
    attn_block<96>(qkv + row0 * QKVW + h * 96, QKVW, qkv + brow * QKVW + 768 + h * 96, QKVW, qkv + brow * QKVW + 1536 + h * 64, QKVW,
                   px + row0 * PXW + PX_MLAO + h * 64, PXW, ntiles, ntiles, 0, 0, nullptr, false, 0.10206207261596577f * L2E, smem);
  };
  for (int t = blockIdx.x; t < 1024; t += gridDim.x) {
    const int r = t >> 8, blk = t & 255, xcd = blk & 7, slot = blk >> 3;
    const int pair = r * 16 + xcd * 2 + (slot >> 4);
    run_mla(pair & 7, pair >> 3, 1 + (slot & 15));
  }
  unsigned* qctr = (unsigned*)(P.ws + OFF_BAR) + 3600 + l;
  volatile LAS unsigned* qslot = (volatile LAS unsigned*)(smem + SMEM_BYTES + 8);
  const int tid = otid();
  const int half = tid >> 8;
  constexpr int QTOT = NA + 576 + 64;
  for (;;) {
    __syncthreads();
    if (tid == 0) *qslot = __hip_atomic_fetch_add(qctr, 1u, __ATOMIC_RELAXED, __HIP_MEMORY_SCOPE_AGENT);
    __syncthreads();
    const int q0 = (int)*qslot;
    if (q0 >= QTOT) break;
    const int q = (q0 < 576) ? (NA + q0) : ((q0 < 576 + NA) ? (q0 - 576) : q0);
    if (q < NA) {
      const int u = q; const int kvh = u & 1, b = (u >> 1) & 7, pb = 67 - (u >> 4);
      const size_t row0 = (size_t)b * NTOK + pb * 64;
      const size_t brow = (size_t)b * NTOK;
      int ntiles = 4, t0b = 0, qpos0 = 0;
      if (pb >= 4) {
        const int start = (pb - 4) * 64;
        const int lo = (start - 128 < 0) ? 0 : (start - 128);
        const int hi = (start + 192 > SEQ) ? SEQ : (start + 192);
        t0b = (CTXL + lo) >> 6; ntiles = 4 + ((hi - lo) >> 6); qpos0 = start;
      }
      attn_block<64>(px + row0 * PXW + PX_SQ + kvh * 256, PXW, px + brow * PXW + PX_SK + kvh * 64, PXW, px + brow * PXW + PX_SV + kvh * 64, PXW,
                     px + row0 * PXW + PX_SWAO + kvh * 256, PXW, ntiles, 4, t0b, qpos0, sinkp + l * 8 + kvh * 4, true, 0.125f * L2E, smem, true);
    } else if (q < NA + 576) {
      const int pr = q - NA;
      const int tt = pr * 2 + half; const int g = tt / 36; const int r2 = tt % 36; const int m0 = (r2 >> 2) * 128, n0 = (r2 & 3) * 128;
      f32x16 acc[2][2];
      gemm_core1<2>(acc, [=](int r, int k) {
        int cc = m0 + r; if (cc > NCHT - 1) cc = NCHT - 1;
        return (k < 512) ? (px + (size_t)(cc * 32 + (k >> 4)) * PXW + PX_U + g * 16 + (k & 15)) : (HIN + ((size_t)cc * 32 + g) * 256 + (k - 512));
      }, MQ + ((size_t)g * 512 + n0) * 768, 768, 768, smem);
      gemm_epi<2>(acc, [=](int r, int c, float v) {
        const int cc = m0 + r; const int n = n0 + c;
        if (cc < NCHT) yact[(size_t)(cc * 32 + (n >> 4)) * 512 + g * 16 + (n & 15)] = (h16)gelu_tanh(v);
      });
    } else {
      const int u = q - NA - 576;
      run_mla(u & 7, u >> 3, 0);
    }
  }
  __syncthreads();
}
DI void ph_glu(CParams* PP_, int l, char* smem) {
  CParams& P = *launder(PP_);
  const h16* W = (const h16*)(P.ws + OFF_W16) + WO_GLU;
  const h16* yact = (const h16*)(P.ws + OFF_YACT);
  h16* px = (h16*)(P.ws + OFF_PX);
  const float* bg = P.in[I_BGLU] + l * 512;
  auto E = [=](const f32x4 (&acc)[2][2][4][2], const pg8::Unit& u, int wr, int wc, int fr, int fq) {
    const int colb = u.pn * 256 + wc * 32 + 8 * fq;
    f32x4 b0[2], b1[2];
#pragma unroll
    for (int bj = 0; bj < 2; ++bj) { b0[bj] = *(const f32x4*)(bg + colb + bj * 128); b1[bj] = *(const f32x4*)(bg + colb + bj * 128 + 4); }
#pragma unroll
    for (int ai = 0; ai < 2; ++ai) {
      h16x8 y[4][2];
#pragma unroll
      for (int m = 0; m < 4; ++m)
#pragma unroll
        for (int bj = 0; bj < 2; ++bj) y[m][bj] = *(const h16x8*)(yact + (size_t)(u.pm * 256 + ai * 128 + wr * 64 + m * 16 + fr) * 512 + colb + bj * 128);
      asm volatile("" ::: "memory");
#pragma unroll
      for (int m = 0; m < 4; ++m)
#pragma unroll
        for (int bj = 0; bj < 2; ++bj) {
          const f32x4 lo = acc[ai][bj][m][0], hi = acc[ai][bj][m][1];
          h16x8 o;
#pragma unroll
          for (int e = 0; e < 4; ++e) { o[e] = (h16)((float)y[m][bj][e] * sigmoidf_(lo[e] + b0[bj][e])); o[4 + e] = (h16)((float)y[m][bj][4 + e] * sigmoidf_(hi[e] + b1[bj][e])); }
          *(h16x8*)(px + (size_t)(u.pm * 256 + ai * 128 + wr * 64 + m * 16 + fr) * PXW + PX_S5O + colb + bj * 128) = o;
        }
    }
  };
  pg8::gemm_fast<true>((LAS unsigned char*)smem, yact, 512, W, 512, 136, 2, E, l == 1);
}
DI void ph_gates(CParams* PP_, int l, char* smem) {
  CParams& P = *launder(PP_);
  const h16* hx = (const h16*)(P.ws + OFF_HX);
  const h16* W = (const h16*)(P.ws + OFF_W16) + WO_IN + (size_t)2048 * 1024;
  h16* gt = (h16*)(P.ws + OFF_GATES);
  auto E = [=](const f32x4 (&acc)[2][2][4][2], const pg8::Unit& u, int wr, int wc, int fr, int fq) {
    pg8::epi8(acc, u, wr, wc, fr, fq, [=](int row, int col, f32x4 lo, f32x4 hi) {
      h16x8 o;
#pragma unroll
      for (int e = 0; e < 4; ++e) { o[e] = (h16)sigmoidf_(lo[e]); o[4 + e] = (h16)sigmoidf_(hi[e]); }
      *(h16x8*)(gt + (size_t)row * 3072 + col) = o;
    });
  };
  pg8::gemm_fast<true>((LAS unsigned char*)smem, hx, 1024, W, 1024, 136, 12, E, l == 1);
}
DI void ph_merge(CParams* PP_, int l, char* smem) {
  CParams& P = *launder(PP_);
  const h16* W = (const h16*)(P.ws + OFF_W16) + WO_BR;
  const h16* px = (const h16*)(P.ws + OFF_PX);
  const h16* gt = (const h16*)(P.ws + OFF_GATES);
  h16* mg = (h16*)(P.ws + OFF_HX);
  {
    auto E = [=](const f32x4 (&acc)[2][2][4][2], const pg8::Unit& u, int wr, int wc, int fr, int fq) {
      const int r3 = u.seg;
      const int colb = u.pn * 256 + wc * 32 + 8 * fq;
#pragma unroll
      for (int ai = 0; ai < 2; ++ai) {
        h16x8 g[4][2], prev[4][2];
#pragma unroll
        for (int m = 0; m < 4; ++m)
#pragma unroll
          for (int bj = 0; bj < 2; ++bj) {
            const size_t row = (size_t)(u.pm * 256 + ai * 128 + wr * 64 + m * 16 + fr);
            g[m][bj] = *(const h16x8*)(gt + row * 3072 + r3 * 1024 + colb + bj * 128);
            if (r3 > 0) prev[m][bj] = *(const h16x8*)(mg + row * 1024 + colb + bj * 128);
          }
        asm volatile("" ::: "memory");
#pragma unroll
        for (int m = 0; m < 4; ++m)
#pragma unroll
          for (int bj = 0; bj < 2; ++bj) {
            const size_t row = (size_t)(u.pm * 256 + ai * 128 + wr * 64 + m * 16 + fr);
            const f32x4 lo = acc[ai][bj][m][0], hi = acc[ai][bj][m][1];
            h16x8 o;
#pragma unroll
            for (int e = 0; e < 4; ++e) {
              float a = (float)g[m][bj][e] * lo[e], bb2 = (float)g[m][bj][4 + e] * hi[e];
              if (r3 > 0) { a += (float)prev[m][bj][e]; bb2 += (float)prev[m][bj][4 + e]; }
              o[e] = (h16)a; o[4 + e] = (h16)bb2;
            }
            *(h16x8*)(mg + row * 1024 + colb + bj * 128) = o;
          }
      }
    };
    pg8::gemm_fast<true>((LAS unsigned char*)smem, px, PXW, W, 512, 136, 4, E, l == 1, 3, PX_MLAO * 2, PX_S5O * 2, PX_SWAO * 2, (size_t)1024 * 512 * 2);
  }
}
DI void ph_resid(CParams* PP_, int l, size_t a_off, int K, size_t w_off, int gate_idx, bool fi_mode, char* smem) {
  CParams& P = *launder(PP_);
  int ll = l; asm volatile("" : "+s"(ll));
  const bool from_in = fi_mode && (ll == 0);
  const h16* A = (const h16*)(P.ws + a_off);
  const h16* Wt = (const h16*)(P.ws + OFF_W16) + w_off;
  const float* mod = (const float*)(P.ws + OFF_MOD) + (size_t)l * 9 * 6144 + gate_idx * 1024;
  float* ctxh = (float*)(P.ws + OFF_CTXH);
  float* outp = P.out;
  const float* src_c = from_in ? P.in[I_CTX] : (const float*)ctxh;
  const float* src_x = from_in ? P.in[I_X] : (const float*)outp;
  auto E = [=](const f32x4 (&acc)[2][2][4][2], const pg8::Unit& u, int wr, int wc, int fr, int fq) {
    const int b = u.pm / 17, jt = u.pm - b * 17;
    const bool isctx = (jt == 0);
    const size_t rbase = isctx ? (size_t)b * CTXL : ((size_t)b * SEQ + (size_t)(jt - 1) * 256);
    const float* src = (isctx ? src_c : src_x) + rbase * 1024;
    float* dst = (isctx ? ctxh : outp) + rbase * 1024;
    const float* gm = mod + (size_t)(isctx ? 8 : b) * 6144;
    const int colb = u.pn * 256 + wc * 32 + 4 * fq;
    f32x4 g[2][2];
#pragma unroll
    for (int bj = 0; bj < 2; ++bj)
#pragma unroll
      for (int n = 0; n < 2; ++n) g[bj][n] = *(const f32x4*)(gm + colb + bj * 128 + 16 * n);
#pragma unroll
    for (int ai = 0; ai < 2; ++ai) {
      f32x4 s0[4][2][2];
#pragma unroll
      for (int m = 0; m < 4; ++m)
#pragma unroll
        for (int bj = 0; bj < 2; ++bj)
#pragma unroll
          for (int n = 0; n < 2; ++n) s0[m][bj][n] = *(const f32x4*)(src + (size_t)(ai * 128 + wr * 64 + m * 16 + fr) * 1024 + colb + bj * 128 + 16 * n);
      asm volatile("" ::: "memory");
#pragma unroll
      for (int m = 0; m < 4; ++m)
#pragma unroll
        for (int bj = 0; bj < 2; ++bj)
#pragma unroll
          for (int n = 0; n < 2; ++n) *(f32x4*)(dst + (size_t)(ai * 128 + wr * 64 + m * 16 + fr) * 1024 + colb + bj * 128 + 16 * n) = s0[m][bj][n] + g[bj][n] * acc[ai][bj][m][n];
    }
  };
  pg8::gemm_fast<false>((LAS unsigned char*)smem, A, K, Wt, K, 136, 4, E, ll == 1);
}
DI void ph_ffn1(CParams* PP_, int l, char* smem) {
  CParams& P = *launder(PP_);
  const h16* hx = (const h16*)(P.ws + OFF_HX);
  const h16* W = (const h16*)(P.ws + OFF_W16) + WO_F1;
  h16* hid = (h16*)(P.ws + OFF_PX);
  auto E = [=](const f32x4 (&acc)[2][2][4][2], const pg8::Unit& u, int wr, int wc, int fr, int fq) {
#pragma unroll
    for (int ai = 0; ai < 2; ++ai)
#pragma unroll
      for (int m = 0; m < 4; ++m) {
        const int row = u.pm * 256 + ai * 128 + wr * 64 + m * 16 + fr;
        const int j0 = u.pn * 128 + wc * 32 + 8 * fq;
        h16x8 o;
#pragma unroll
        for (int n = 0; n < 2; ++n)
#pragma unroll
          for (int e = 0; e < 4; ++e) { const float a = acc[ai][0][m][n][e], g = acc[ai][1][m][n][e]; o[4 * n + e] = (h16)(a * sigmoidf_(a) * g); }
        *(h16x8*)(hid + (size_t)row * FFH + j0) = o;
      }
  };
  pg8::gemm_fast<true>((LAS unsigned char*)smem, hx, 1024, W, 1024, 136, 22, E, l == 1);
}

__global__ void __launch_bounds__(512, 2) fwd_mega(Params Pk) {
  CParams* P = (CParams*)__builtin_amdgcn_kernarg_segment_ptr();
  cg::grid_group grid = cg::this_grid();
  extern __shared__ __attribute__((aligned(16))) char smem[];
  volatile LAS unsigned* xst = (volatile LAS unsigned*)(smem + SMEM_BYTES);
  if (threadIdx.x == 0) { xst[0] = 0u; xst[1] = 0u; }
  __syncthreads();
  (void)xcd_barrier_post((unsigned*)(launder(P)->ws + OFF_BAR), xst);
  if (P->ws == nullptr) grid.sync();
  ph_ada(P, smem);
  ph_convert(P, 0, smem);
  ph_s5pow(P);
  xcd_barrier(P, xst);
  for (int l = 0; l < 2; ++l) {
    ph_norm(P, l, 0);
    if (l == 1) ph_convert(P, 1, smem);
    xcd_barrier(P, xst);
    ph_gemm_in(P, smem);
    ph_s5lag(P, l, smem);
    xcd_barrier(P, xst);
    ph_prep(P, l);
    ph_s5mats(P, l);
    xcd_barrier(P, xst);
    ph_upproj(P, l, smem);
    xcd_barrier(P, xst);
    ph_final(P, l);
    ph_s5scan(P, l);
    xcd_barrier(P, xst);
    ph_mix(P, l, smem);
    xcd_barrier(P, xst);
    ph_glu(P, l, smem);
    xcd_barrier(P, xst);
    ph_gates(P, l, smem);
    xcd_barrier(P, xst);
    ph_merge(P, l, smem);
    xcd_barrier(P, xst);
    ph_resid(P, l, OFF_HX, 1024, WO_OUT, 2, true, smem);
    xcd_barrier(P, xst);
    ph_norm(P, l, 1);
    xcd_barrier(P, xst);
    ph_ffn1(P, l, smem);
    xcd_barrier(P, xst);
    ph_resid(P, l, OFF_PX, FFH, WO_F2, 5, false, smem);
    if (l == 0) xcd_barrier(P, xst);
  }
}

extern "C" void kernel_launch(void* const* d_in, const int* in_sizes, int n_in,
                              void* d_out, int out_size, void* d_ws, size_t ws_size,
                              hipStream_t stream) {
  static int grid_blocks = 0;
  if (!grid_blocks) {
    int dev = 0, cus = 0, per_cu = 0;
    (void)hipGetDevice(&dev);
    (void)hipDeviceGetAttribute(&cus, hipDeviceAttributeMultiprocessorCount, dev);
    (void)hipFuncSetAttribute((const void*)fwd_mega, hipFuncAttributeMaxDynamicSharedMemorySize, DYN_LDS);
    (void)hipOccupancyMaxActiveBlocksPerMultiprocessor(&per_cu, fwd_mega, NT, DYN_LDS);
    (void)hipGetLastError();
    grid_blocks = cus;
  }
  if (ws_size < WS_NEED || n_in != 30) { fprintf(stderr, "kernel_launch: ws too small (%zu < %zu) or n_in %d\n", ws_size, (size_t)WS_NEED, n_in); return; }
  (void)hipMemsetAsync((char*)d_ws + OFF_BAR, 0, 16384, stream);
  Params p{};
  for (int i = 0; i < 30; ++i) p.in[i] = (const float*)d_in[i];
  p.out = (float*)d_out;
  p.ws = (char*)d_ws;
  void* args[] = {&p};
  hipError_t e = hipLaunchCooperativeKernel((void*)fwd_mega, dim3(grid_blocks), dim3(NT), args, DYN_LDS, stream);
  if (e != hipSuccess) fprintf(stderr, "cooperative launch failed: %s (grid %d)\n", hipGetErrorString(e), grid_blocks);
}
```
